# Optimizing an MI355X kernel written in HIP

```python
import jax, jax.numpy as jnp
from jax import lax
import numpy as np

D_MODEL = 1024
BATCH = 4
SEQ = 8192
DEPTH = 4

HEAD_DIM = 64
ATT_HEADS = 6
D_ATT = ATT_HEADS * HEAD_DIM
D_CONV = 256
CONV_WIDTH = 31
HGRN_HEADS = 6
D_HGRN = HGRN_HEADS * HEAD_DIM
D_MIX = D_ATT + D_CONV + D_HGRN
D_FF = -(-8 * D_MODEL // (3 * 256)) * 256
Q_BLOCK = 128
CHUNK = 64
IN_SIZES = (D_ATT, D_ATT, D_ATT, ATT_HEADS, 2 * D_CONV, D_HGRN, D_HGRN, D_HGRN, D_HGRN)
D_IN = D_ATT * 3 + ATT_HEADS + 2 * D_CONV + D_HGRN * 4
RMS_EPS = 1e-6
LN_EPS = 1e-5

kernel_name = "hybrid_fox_conformer_hgrn2_trunk"


def _split_points():
    pts, acc = [], 0
    for s in IN_SIZES[:-1]:
        acc += s
        pts.append(acc)
    return pts


def _rmsnorm(x, g):
    xf = x.astype(jnp.float32)
    y = xf * lax.rsqrt(jnp.mean(xf * xf, axis=-1, keepdims=True) + RMS_EPS)
    return (y * g.astype(jnp.float32)).astype(x.dtype)


def _layernorm(x, g, b):
    xf = x.astype(jnp.float32)
    mu = jnp.mean(xf, axis=-1, keepdims=True)
    xc = xf - mu
    var = jnp.mean(xc * xc, axis=-1, keepdims=True)
    y = xc * lax.rsqrt(var + LN_EPS)
    return (y * g.astype(jnp.float32) + b.astype(jnp.float32)).astype(x.dtype)


def _heads(t, n):
    B, T, _ = t.shape
    return t.reshape(B, T, n, -1).transpose(0, 2, 1, 3)


def _merge(t):
    B, H, T, Dh = t.shape
    return t.transpose(0, 2, 1, 3).reshape(B, T, H * Dh)


def forgetting_attention(q, k, v, log_f):
    B, H, T, Dh = q.shape
    nb = T // Q_BLOCK
    c = jnp.cumsum(log_f.astype(jnp.float32), axis=-1)
    qb = q.reshape(B, H, nb, Q_BLOCK, Dh).transpose(2, 0, 1, 3, 4)
    cb = c.reshape(B, H, nb, Q_BLOCK).transpose(2, 0, 1, 3)
    kpos = jnp.arange(T)
    scale = HEAD_DIM ** -0.5

    def one_block(args):
        i, q_i, c_i = args
        s = jnp.einsum('bhqd,bhkd->bhqk', q_i, k).astype(jnp.float32) * scale
        s = s + (c_i[..., :, None] - c[..., None, :])
        qpos = i * Q_BLOCK + jnp.arange(Q_BLOCK)
        causal = kpos[None, :] <= qpos[:, None]
        s = jnp.where(causal, s, -jnp.inf)
        p = jax.nn.softmax(s, axis=-1).astype(v.dtype)
        return jnp.einsum('bhqk,bhkd->bhqd', p, v)

    o = lax.map(one_block, (jnp.arange(nb), qb, cb))
    return o.transpose(1, 2, 0, 3, 4).reshape(B, H, T, Dh)


def conformer_conv(u, conv_w, conv_b, ln_g, ln_b):
    a, gate = jnp.split(u, 2, axis=-1)
    h = a * jax.nn.sigmoid(gate)
    h = lax.conv_general_dilated(
        h, conv_w[:, None, :], window_strides=(1,), padding=[(CONV_WIDTH - 1, 0)],
        dimension_numbers=('NWC', 'WIO', 'NWC'), feature_group_count=D_CONV) + conv_b
    h = _layernorm(h, ln_g, ln_b)
    return jax.nn.silu(h)


def hgrn2_recurrence(q, k, v, log_f):
    B, H, T, Dk = q.shape
    Dv = v.shape[-1]
    nc = T // CHUNK

    def to_chunks(t):
        return t.reshape(B, H, nc, CHUNK, t.shape[-1]).transpose(2, 0, 1, 3, 4)

    tri = jnp.tril(jnp.ones((CHUNK, CHUNK), dtype=bool))

    def step(S, inp):
        q_c, k_c, v_c, g_c = inp
        b = jnp.cumsum(g_c, axis=-2)
        diff = b[..., :, None, :] - b[..., None, :, :]
        decay = jnp.exp(jnp.where(tri[:, :, None], diff, -jnp.inf))
        a = jnp.einsum('bhtd,bhtsd,bhsd->bhts', q_c, decay, k_c)
        o = (jnp.einsum('bhts,bhsv->bhtv', a, v_c)
             + jnp.einsum('bhtd,bhdv->bhtv', q_c * jnp.exp(b), S))
        b_end = b[..., -1:, :]
        S = (jnp.exp(b_end[..., 0, :])[..., None] * S
             + jnp.einsum('bhsd,bhsv->bhdv', k_c * jnp.exp(b_end - b), v_c))
        return S, o

    S0 = jnp.zeros((B, H, Dk, Dv), jnp.float32)
    _, o = lax.scan(step, S0, (to_chunks(q), to_chunks(k), to_chunks(v), to_chunks(log_f)))
    return o.transpose(1, 2, 0, 3, 4).reshape(B, H, T, Dv)


def setup_inputs(seed: int = 0) -> dict:
    key = jax.random.key(seed)
    ks = jax.random.split(key, 16)
    f32 = jnp.float32

    def nrm(k, shape, scale):
        return jax.random.normal(k, shape, f32) * scale

    res_scale = (2 * DEPTH) ** -0.5
    return {
        "x": nrm(ks[0], (BATCH, SEQ, D_MODEL), 1.0),
        "norm_mix_g": 1.0 + nrm(ks[1], (DEPTH, D_MODEL), 0.02),
        "w_in": nrm(ks[2], (DEPTH, D_MODEL, D_IN), D_MODEL ** -0.5),
        "fgate_b": 2.0 + nrm(ks[3], (DEPTH, ATT_HEADS), 0.1),
        "conv_w": nrm(ks[4], (DEPTH, CONV_WIDTH, D_CONV), CONV_WIDTH ** -0.5),
        "conv_b": nrm(ks[5], (DEPTH, D_CONV), 0.02),
        "conv_ln_g": 1.0 + nrm(ks[6], (DEPTH, D_CONV), 0.02),
        "conv_ln_b": nrm(ks[7], (DEPTH, D_CONV), 0.02),
        "hgrn_lb_logits": nrm(ks[8], (DEPTH, D_HGRN), 0.5),
        "hgrn_norm_g": 1.0 + nrm(ks[9], (DEPTH, HEAD_DIM), 0.02),
        "w_out": nrm(ks[10], (DEPTH, D_MIX, D_MODEL), D_MIX ** -0.5 * res_scale),
        "norm_ffn_g": 1.0 + nrm(ks[11], (DEPTH, D_MODEL), 0.02),
        "w_ffn_in": nrm(ks[12], (DEPTH, D_MODEL, 2 * D_FF), D_MODEL ** -0.5),
        "w_ffn_out": nrm(ks[13], (DEPTH, D_FF, D_MODEL), D_FF ** -0.5 * res_scale),
        "norm_final_g": 1.0 + nrm(ks[14], (D_MODEL,), 0.02),
    }


def reference(x, norm_mix_g, w_in, fgate_b, conv_w, conv_b, conv_ln_g, conv_ln_b,
              hgrn_lb_logits, hgrn_norm_g, w_out, norm_ffn_g, w_ffn_in, w_ffn_out, norm_final_g):
    f32 = jnp.float32
    lb_all = jnp.cumsum(jax.nn.softmax(hgrn_lb_logits.astype(f32), axis=0), axis=0)
    lb_all = lb_all - lb_all[0:1]
    split_pts = _split_points()

    for l in range(DEPTH):
        h = _rmsnorm(x, norm_mix_g[l])
        z = h @ w_in[l]
        q_a, k_a, v_a, f_a, c_in, q_h, f_h, i_h, g_h = jnp.split(z, split_pts, axis=-1)

        log_fa = jax.nn.log_sigmoid(f_a.astype(f32) + fgate_b[l].astype(f32)).transpose(0, 2, 1)
        att = _merge(forgetting_attention(_heads(q_a, ATT_HEADS), _heads(k_a, ATT_HEADS),
                                          _heads(v_a, ATT_HEADS), log_fa))

        cnv = conformer_conv(c_in, conv_w[l], conv_b[l], conv_ln_g[l], conv_ln_b[l])

        lb = lb_all[l]
        f = lb + (1.0 - lb) * jax.nn.sigmoid(f_h.astype(f32))
        o_h = hgrn2_recurrence(_heads(q_h.astype(f32), HGRN_HEADS), _heads(1.0 - f, HGRN_HEADS),
                               _heads(i_h.astype(f32), HGRN_HEADS), _heads(jnp.log(f), HGRN_HEADS))
        o_h = _rmsnorm(o_h, hgrn_norm_g[l])
        hg = _merge(o_h).astype(x.dtype) * jax.nn.silu(g_h)

        mix = jnp.concatenate([att.astype(x.dtype), cnv.astype(x.dtype), hg], axis=-1) @ w_out[l]
        x = x + mix

        h = _rmsnorm(x, norm_ffn_g[l])
        gate, up = jnp.split(h @ w_ffn_in[l], 2, axis=-1)
        x = x + (jax.nn.silu(gate) * up) @ w_ffn_out[l]

    return _rmsnorm(x, norm_final_g)
```

```cpp
#include <hip/hip_runtime.h>
#include <hip/hip_cooperative_groups.h>
#include <cstdio>
#include <cstdint>
namespace cg = cooperative_groups;
__device__ __forceinline__ int opaque_tid() { int t = threadIdx.x; asm volatile("" : "+v"(t)); return t; }
namespace pg8 {
#define PG8_LAS __attribute__((address_space(3)))
typedef unsigned short bf16_t;
typedef short bf16x8 __attribute__((ext_vector_type(8)));
typedef float f32x4 __attribute__((ext_vector_type(4)));
typedef unsigned u32x4 __attribute__((ext_vector_type(4)));
constexpr int BM = 256, BK = 64, HALF = 128, HTB = HALF * BK * 2  , STAGE_BYTES = 8 * HTB, NXCD = 8, WGM = 8;

__host__ __device__ __forceinline__ int lds_byte(int r, int c) { const int st = (r >> 4) * 2 + (c >> 5), rr = r & 15, cc = c & 31, ob = rr * 64 + cc * 2; return st * 1024 + (ob ^ (((ob >> 9) & 1) << 5)); }
__host__ __device__ __forceinline__ void stage_rc(int b, int& R, int& C) { const int st = b / 1024, sb = b % 1024, swz = sb ^ (((sb >> 9) & 1) << 5); R = (st >> 1) * 16 + swz / 64; C = (st & 1) * 32 + (swz % 64) / 2; }
__host__ __device__ __forceinline__ int perm32(int rho) { const int n = rho >> 4, i = rho & 15; return 8 * (i >> 2) + 4 * n + (i & 3); }

struct Unit { int pm, pn; };
struct Gemm { const bf16_t* A; const bf16_t* Bt; int M, N, K; };

struct StaticOrder {
    int nM, nN, nwg, G, c;
    __host__ __device__ void init(int M, int N, int G_, int c_) { nM = M / BM; nN = N / BM; nwg = nM * nN; G = G_; c = c_; }
    __host__ __device__ bool next(int i, Unit& u) const {
        const long L = (long)i * G + c; if (L >= nwg) return false;
        int wgid = (int)L; { const int q = nwg / NXCD, r = nwg % NXCD, xcd = wgid % NXCD, off = wgid / NXCD; wgid = (xcd < r ? xcd * (q + 1) : r * (q + 1) + (xcd - r) * q) + off; }
        const int nig = WGM * nN, gid = wgid / nig, fm = gid * WGM, gsz = (nM - fm) < WGM ? (nM - fm) : WGM;
        u.pm = fm + ((wgid % nig) % gsz); u.pn = (wgid % nig) / gsz; return true;
    }
    __device__ __forceinline__ void a_ready(const Unit&) const {}
    __device__ __forceinline__ void done(const Unit&) const {}
};

__device__ __forceinline__ unsigned cvt_pk_bf16(float lo, float hi) { unsigned r; asm volatile("v_cvt_pk_bf16_f32 %0, %1, %2" : "=v"(r) : "v"(lo), "v"(hi)); return r; }
typedef float f32x2 __attribute__((ext_vector_type(2)));
template <class Epi, class Sched, bool ALIGN_EPI = false, bool SP2 = false>
__device__ __forceinline__ void gemm_phase(PG8_LAS unsigned char* lds, const Gemm g, const Sched& S, const Epi& E) {
    const int tid = opaque_tid(), wid = __builtin_amdgcn_readfirstlane(tid >> 6), lane = tid & 63, wr = wid >> 2, wc = wid & 3, fr = lane & 15, fq = lane >> 4;
    const int K = g.K, nt = K / BK;
    unsigned voffA[2], voffB[2];
#pragma unroll
    for (int i = 0; i < 2; ++i) { int R, C; stage_rc(tid * 16 + i * 8192, R, C); const int Rb = Epi::PERM ? ((R & ~31) + perm32(R & 31)) : R;
        voffA[i] = (unsigned)(R * K + C) * 2u; voffB[i] = (unsigned)(Rb * K + C) * 2u; }
    const size_t kstep = (size_t)(BK * 2);
    const size_t hstep = (size_t)HALF * K * 2;
    const size_t tstep = 2 * hstep;
    const unsigned ldsw = (unsigned)wid * 1024u;
    const int aoff = lds_byte(wr * 64 + fr, fq * 8), boff = lds_byte(wc * 32 + fr, fq * 8);
#define PG8_SA(b, h) (((b) * 2 + (h)) * HTB)
#define PG8_SB(b, h) ((4 + (b) * 2 + (h)) * HTB)
#define PG8_STAGE(bufoff, gbase, voff) do { _Pragma("unroll") for (int _i = 0; _i < 2; ++_i) \
        __builtin_amdgcn_global_load_lds((const unsigned*)((const char*)(gbase) + (voff)[_i]), (PG8_LAS unsigned*)(lds + (bufoff) + ldsw + _i * 8192), 16, 0, 0); } while (0)
#define PG8_LDA(dst, b, h) do { _Pragma("unroll") for (int m = 0; m < 4; ++m) _Pragma("unroll") for (int k = 0; k < 2; ++k) dst[m][k] = *(const PG8_LAS bf16x8*)(lds + PG8_SA(b, h) + aoff + m * 2048 + k * 1024); } while (0)
#define PG8_LDB(dst, b, h) do { _Pragma("unroll") for (int n = 0; n < 2; ++n) _Pragma("unroll") for (int k = 0; k < 2; ++k) dst[n][k] = *(const PG8_LAS bf16x8*)(lds + PG8_SB(b, h) + boff + n * 2048 + k * 1024); } while (0)
#define PG8_MMA(ai, bj, At, Bt) do { __builtin_amdgcn_s_setprio(1); _Pragma("unroll") for (int m = 0; m < 4; ++m) _Pragma("unroll") for (int n = 0; n < 2; ++n) _Pragma("unroll") for (int k = 0; k < 2; ++k) \
        acc[ai][bj][m][n] = __builtin_amdgcn_mfma_f32_16x16x32_bf16(Bt[n][k], At[m][k], acc[ai][bj][m][n], 0, 0, 0); __builtin_amdgcn_s_setprio(0); } while (0)
#define PG8_WAIT_V(n) asm volatile("s_waitcnt vmcnt(" #n ")" ::: "memory")
#define PG8_WAIT_L(n) asm volatile("s_waitcnt lgkmcnt(" #n ")" ::: "memory")
#define PG8_BAR __builtin_amdgcn_s_barrier()
#define PG8_SCHED __builtin_amdgcn_sched_barrier(0)
    Unit cur, nxt; int ui = 0;
    if (!S.next(0, cur)) return;
    f32x4 acc[2][2][4][2];
#pragma unroll
    for (int a = 0; a < 2; ++a)
#pragma unroll
        for (int b = 0; b < 2; ++b)
#pragma unroll
            for (int m = 0; m < 4; ++m)
#pragma unroll
                for (int n = 0; n < 2; ++n) acc[a][b][m][n] = (f32x4){0.f, 0.f, 0.f, 0.f};
    bf16x8 At[4][2], B0[2][2], B1[2][2];
    const char* cA = (const char*)g.A + (size_t)cur.pm * tstep; const char* cB = (const char*)g.Bt + (size_t)cur.pn * tstep;
    S.a_ready(cur);
    if constexpr (SP2) {
        PG8_STAGE(PG8_SB(0, 0), cB, voffB); PG8_STAGE(PG8_SB(0, 1), cB + hstep, voffB); PG8_STAGE(PG8_SA(0, 0), cA, voffA); PG8_STAGE(PG8_SA(0, 1), cA + hstep, voffA);
        if (wr == 1) PG8_BAR;
        PG8_WAIT_V(2); PG8_BAR;
        PG8_STAGE(PG8_SB(1, 0), cB + kstep, voffB); PG8_STAGE(PG8_SA(1, 0), cA + kstep, voffA); PG8_STAGE(PG8_SB(1, 1), cB + hstep + kstep, voffB);
        PG8_WAIT_V(6); PG8_BAR;
    } else {
        PG8_STAGE(PG8_SB(0, 0), cB, voffB); PG8_STAGE(PG8_SA(0, 0), cA, voffA); PG8_STAGE(PG8_SB(0, 1), cB + hstep, voffB); PG8_STAGE(PG8_SA(0, 1), cA + hstep, voffA);
        if (wr == 1) PG8_BAR;
        PG8_WAIT_V(4); PG8_BAR;
        PG8_STAGE(PG8_SB(1, 0), cB + kstep, voffB); PG8_STAGE(PG8_SA(1, 0), cA + kstep, voffA); PG8_STAGE(PG8_SB(1, 1), cB + hstep + kstep, voffB);
        PG8_WAIT_V(6); PG8_BAR;
    }
    for (;;) {
        const bool has_next = S.next(ui + 1, nxt);
        const char* nA = has_next ? (const char*)g.A + (size_t)nxt.pm * tstep : cA; const char* nB = has_next ? (const char*)g.Bt + (size_t)nxt.pn * tstep : cB;
        for (int t = 0; t < nt; t += 2) {
            const bool last = (t == nt - 2);
            const char* a1 = cA + (size_t)(t + 1) * kstep;
            const char* a2 = last ? nA : cA + (size_t)(t + 2) * kstep; const char* b2 = last ? nB : cB + (size_t)(t + 2) * kstep;
            const char* a3 = a2 + kstep; const char* b3 = b2 + kstep;
            if (last && has_next) S.a_ready(nxt);
            if constexpr (SP2) {
            PG8_LDB(B0, 0, 0); PG8_LDB(B1, 0, 1); PG8_SCHED; PG8_LDA(At, 0, 0); PG8_STAGE(PG8_SA(1, 1), a1 + hstep, voffA);
            PG8_WAIT_V(8); PG8_WAIT_L(0); PG8_BAR; PG8_MMA(0, 0, At, B0); PG8_MMA(0, 1, At, B1); PG8_BAR; PG8_SCHED;
            PG8_LDA(At, 0, 1); PG8_STAGE(PG8_SB(0, 0), b2, voffB); PG8_STAGE(PG8_SB(0, 1), b2 + hstep, voffB); PG8_STAGE(PG8_SA(0, 0), a2, voffA);
            PG8_WAIT_V(8); PG8_WAIT_L(0); PG8_BAR; PG8_MMA(1, 0, At, B0); PG8_MMA(1, 1, At, B1); PG8_BAR; PG8_SCHED;
            PG8_LDB(B0, 1, 0); PG8_LDB(B1, 1, 1); PG8_SCHED; PG8_LDA(At, 1, 0); PG8_STAGE(PG8_SA(0, 1), a2 + hstep, voffA);
            PG8_WAIT_V(8); PG8_WAIT_L(0); PG8_BAR; PG8_MMA(0, 0, At, B0); PG8_MMA(0, 1, At, B1); PG8_BAR; PG8_SCHED;
            PG8_LDA(At, 1, 1); PG8_STAGE(PG8_SB(1, 0), b3, voffB); PG8_STAGE(PG8_SB(1, 1), b3 + hstep, voffB); PG8_STAGE(PG8_SA(1, 0), a3, voffA);
            PG8_WAIT_V(8); PG8_WAIT_L(0); PG8_BAR; PG8_MMA(1, 0, At, B0); PG8_MMA(1, 1, At, B1); PG8_BAR; PG8_SCHED;
            } else {
            PG8_LDB(B0, 0, 0); PG8_SCHED; PG8_LDA(At, 0, 0); PG8_STAGE(PG8_SA(1, 1), a1 + hstep, voffA);
            PG8_WAIT_L(8); PG8_BAR; PG8_WAIT_L(0); PG8_MMA(0, 0, At, B0); PG8_BAR; PG8_SCHED;
            PG8_LDB(B1, 0, 1); PG8_STAGE(PG8_SB(0, 0), b2, voffB);
            PG8_BAR; PG8_WAIT_L(0); PG8_MMA(0, 1, At, B1); PG8_BAR;
            PG8_LDA(At, 0, 1); PG8_STAGE(PG8_SA(0, 0), a2, voffA);
            PG8_BAR; PG8_WAIT_L(0); PG8_MMA(1, 0, At, B0); PG8_BAR; PG8_SCHED;
            PG8_STAGE(PG8_SB(0, 1), b2 + hstep, voffB);
            PG8_WAIT_V(6); PG8_BAR; PG8_MMA(1, 1, At, B1); PG8_BAR;
            PG8_LDB(B0, 1, 0); PG8_SCHED; PG8_LDA(At, 1, 0); PG8_STAGE(PG8_SA(0, 1), a2 + hstep, voffA);
            PG8_WAIT_L(8); PG8_BAR; PG8_WAIT_L(0); PG8_MMA(0, 0, At, B0); PG8_BAR; PG8_SCHED;
            PG8_LDB(B1, 1, 1); PG8_STAGE(PG8_SB(1, 0), b3, voffB);
            PG8_BAR; PG8_WAIT_L(0); PG8_MMA(0, 1, At, B1); PG8_BAR;
            PG8_LDA(At, 1, 1); PG8_STAGE(PG8_SA(1, 0), a3, voffA);
            PG8_BAR; PG8_WAIT_L(0); PG8_MMA(1, 0, At, B0); PG8_BAR; PG8_SCHED;
            PG8_STAGE(PG8_SB(1, 1), b3 + hstep, voffB);
            PG8_WAIT_V(6); PG8_BAR; PG8_MMA(1, 1, At, B1); PG8_BAR;
            }
        }
        if constexpr (ALIGN_EPI) { if (wr == 0) PG8_BAR; }
        if constexpr (!Epi::AFTER_DRAIN) { E(acc, cur, wr, wc, fr, fq); S.done(cur); }
        if (!has_next) break;
#pragma unroll
        for (int a = 0; a < 2; ++a)
#pragma unroll
            for (int b = 0; b < 2; ++b)
#pragma unroll
                for (int m = 0; m < 4; ++m)
#pragma unroll
                    for (int n = 0; n < 2; ++n) acc[a][b][m][n] = (f32x4){0.f, 0.f, 0.f, 0.f};
        cur = nxt; cA = nA; cB = nB; ++ui;
        if constexpr (ALIGN_EPI) { if (wr == 1) PG8_BAR; }
    }
    PG8_WAIT_V(0);
    if constexpr (!ALIGN_EPI) { if (wr == 0) PG8_BAR; }
    PG8_BAR;
    if constexpr (Epi::AFTER_DRAIN) { E.fused(acc, cur, wr, wc, fr, fq, lds, wid, lane); S.done(cur); }
#undef PG8_SA
#undef PG8_SB
#undef PG8_STAGE
#undef PG8_LDA
#undef PG8_LDB
#undef PG8_MMA
#undef PG8_WAIT_V
#undef PG8_WAIT_L
#undef PG8_BAR
#undef PG8_SCHED
}
}
#define LAS __attribute__((address_space(3)))
typedef unsigned short bf16_t;
typedef short bf16x8 __attribute__((ext_vector_type(8)));
typedef short s16x4 __attribute__((ext_vector_type(4)));
typedef float f32x4 __attribute__((ext_vector_type(4)));
typedef float f32x16 __attribute__((ext_vector_type(16)));
typedef unsigned u32x4 __attribute__((ext_vector_type(4)));
typedef unsigned u32x2 __attribute__((ext_vector_type(2)));
typedef float f32x2_t __attribute__((ext_vector_type(2)));
typedef __bf16 bf16x2_t __attribute__((ext_vector_type(2)));

constexpr int NBATCH = 4, T = 8192, D = 1024, DEPTH = 4, M = NBATCH * T;
constexpr int DIN = 3206, NIN = 3328, DFF = 2816, NFF = 5632;
constexpr int ZP = 2816, ZFP = 512;
constexpr int Z_QA = 0, Z_KA = 384, Z_VA = 768, Z_CV = 1152, Z_QH = 1664, Z_IH = 2048, Z_GH = 2432;
constexpr int ZF_FH = 0, ZF_FA = 384;
constexpr int MIX_ATT = 0, MIX_CNV = 384, MIX_HG = 640;
constexpr float LOG2E = 1.4426950408889634f;
constexpr float QSCALE = 0.125f * LOG2E;
constexpr int NHITEM = NBATCH * 6 * 128;
constexpr size_t MiB = 1u << 20;
constexpr size_t WS_WIN = 1 * MiB, WS_WOUT = 27 * MiB, WS_WFI = 35 * MiB, WS_WFO = 79 * MiB, WS_Z = 101 * MiB, WS_ZF = 277 * MiB, WS_XB = 341 * MiB,
                 WS_MIX = 405 * MiB, WS_KT = 469 * MiB, WS_SSQ = 493 * MiB, WS_CS = 495 * MiB, WS_KPM = 496 * MiB, WS_EM = 497 * MiB, WS_EE = 498 * MiB, WS_END = 499 * MiB;
constexpr int LDS_BYTES = 135168;

struct Args {
    const float *x, *norm_mix_g, *w_in, *fgate_b, *conv_w, *conv_b, *conv_ln_g, *conv_ln_b, *lb_logits, *hgrn_norm_g, *w_out, *norm_ffn_g, *w_ffn_in, *w_ffn_out, *norm_final_g;
    float* out; unsigned char* ws;
};

__device__ __forceinline__ unsigned cvtpk(float lo, float hi) { f32x2_t v = {lo, hi}; bf16x2_t b = __builtin_convertvector(v, bf16x2_t); return __builtin_bit_cast(unsigned, b); }
__device__ __forceinline__ float bf2f(unsigned short u) { return __uint_as_float((unsigned)u << 16); }
__device__ __forceinline__ float bflo(unsigned u) { return __uint_as_float(u << 16); }
__device__ __forceinline__ float bfhi(unsigned u) { return __uint_as_float(u & 0xffff0000u); }
__device__ __forceinline__ unsigned short f2bf(float f) { return (unsigned short)(cvtpk(f, 0.f) & 0xffffu); }
__device__ __forceinline__ float fast_rcp(float x) { return __builtin_amdgcn_rcpf(x); }
__device__ __forceinline__ float sigmoidf_(float x) { return fast_rcp(1.f + __expf(-x)); }
__device__ __forceinline__ float siluf_(float x) { return x * fast_rcp(1.f + __expf(-x)); }
__device__ __forceinline__ int crow(int r, int hi) { return (r & 3) + 8 * (r >> 2) + 4 * hi; }
__device__ __forceinline__ s16x4 trread(const LAS unsigned char* p) { typedef short v4i16_t __attribute__((ext_vector_type(4))); return __builtin_bit_cast(s16x4, __builtin_amdgcn_ds_read_tr16_b64_v4i16((LAS v4i16_t*)p)); }
__device__ __forceinline__ bf16x8 cat8(s16x4 lo, s16x4 hi) { return (bf16x8){lo[0], lo[1], lo[2], lo[3], hi[0], hi[1], hi[2], hi[3]}; }
__device__ __forceinline__ float wave_sum(float v) {
#pragma unroll
    for (int o = 1; o < 64; o <<= 1) v += __shfl_xor(v, o);
    return v;
}

__device__ __forceinline__ float row_rstd(const float* ssq, int row, int fq) {
    const f32x4 p = *(const f32x4*)(ssq + (size_t)row * 16 + 4 * fq);
    float s = (p[0] + p[1]) + (p[2] + p[3]); s += __shfl_xor(s, 16); s += __shfl_xor(s, 32);
    return rsqrtf(s * (1.0f / D) + 1e-6f);
}
struct EpiIn {
    static constexpr bool PERM = true, AFTER_DRAIN = false;
    bf16_t* Z; float* ZF; const float* ssq;
    __device__ __forceinline__ void operator()(const pg8::f32x4 (&acc)[2][2][4][2], const pg8::Unit& u, int wr, int wc, int fr, int fq) const {
        const int row0 = u.pm * 256 + wr * 64 + fr, col0 = u.pn * 256 + wc * 32 + 8 * fq;
#pragma unroll
        for (int ai = 0; ai < 2; ++ai)
#pragma unroll
            for (int m = 0; m < 4; ++m) {
                const int row = row0 + ai * 128 + m * 16; const float rs = row_rstd(ssq, row, fq);
#pragma unroll
                for (int bj = 0; bj < 2; ++bj) {
                    const f32x4 v0 = acc[ai][bj][m][0] * rs, v1 = acc[ai][bj][m][1] * rs; const int c = col0 + bj * 128;
                    if (u.pn < 11) { u32x4 w; w.x = cvtpk(v0[0], v0[1]); w.y = cvtpk(v0[2], v0[3]); w.z = cvtpk(v1[0], v1[1]); w.w = cvtpk(v1[2], v1[3]); *(u32x4*)(Z + (size_t)row * ZP + c) = w; }
                    else { float* p = ZF + (size_t)row * ZFP + (c - 2816); *(f32x4*)p = v0; *(f32x4*)(p + 4) = v1; }
                }
            }
    }
};
struct EpiRes {
    static constexpr bool PERM = true, AFTER_DRAIN = false;
    const float* base; float* out; bf16_t* xb; float* ssq;
    __device__ __forceinline__ void operator()(const pg8::f32x4 (&acc)[2][2][4][2], const pg8::Unit& u, int wr, int wc, int fr, int fq) const {
        const int row0 = u.pm * 256 + wr * 64 + fr, col0 = u.pn * 256 + wc * 32 + 8 * fq;
#pragma unroll
        for (int ai = 0; ai < 2; ++ai)
#pragma unroll
            for (int m = 0; m < 4; ++m) {
                const int row = row0 + ai * 128 + m * 16; float q = 0.f;
#pragma unroll
                for (int bj = 0; bj < 2; ++bj) {
                    const size_t off = (size_t)row * D + col0 + bj * 128;
                    const f32x4 v0 = acc[ai][bj][m][0] + *(const f32x4*)(base + off), v1 = acc[ai][bj][m][1] + *(const f32x4*)(base + off + 4);
                    *(f32x4*)(out + off) = v0; *(f32x4*)(out + off + 4) = v1;
                    u32x4 w; w.x = cvtpk(v0[0], v0[1]); w.y = cvtpk(v0[2], v0[3]); w.z = cvtpk(v1[0], v1[1]); w.w = cvtpk(v1[2], v1[3]); *(u32x4*)(xb + off) = w;
                    q += (v0[0] * v0[0] + v0[1] * v0[1]) + (v0[2] * v0[2] + v0[3] * v0[3]) + (v1[0] * v1[0] + v1[1] * v1[1]) + (v1[2] * v1[2] + v1[3] * v1[3]);
                }
                q += __shfl_xor(q, 16); q += __shfl_xor(q, 32);
                if (fq == 0) ssq[(size_t)row * 16 + u.pn * 4 + wc] = q;
            }
    }
};
struct EpiGlu {
    static constexpr bool PERM = true, AFTER_DRAIN = false;
    bf16_t* H; const float* ssq;
    __device__ __forceinline__ void operator()(const pg8::f32x4 (&acc)[2][2][4][2], const pg8::Unit& u, int wr, int wc, int fr, int fq) const {
        const int row0 = u.pm * 256 + wr * 64 + fr, col0 = u.pn * 128 + wc * 32 + 8 * fq;
#pragma unroll
        for (int ai = 0; ai < 2; ++ai)
#pragma unroll
            for (int m = 0; m < 4; ++m) {
                const int row = row0 + ai * 128 + m * 16; const float rs = row_rstd(ssq, row, fq);
                float hv[8];
#pragma unroll
                for (int n = 0; n < 2; ++n)
#pragma unroll
                    for (int e = 0; e < 4; ++e) { const float g = acc[ai][0][m][n][e] * rs, up = acc[ai][1][m][n][e] * rs; hv[n * 4 + e] = siluf_(g) * up; }
                u32x4 w; w.x = cvtpk(hv[0], hv[1]); w.y = cvtpk(hv[2], hv[3]); w.z = cvtpk(hv[4], hv[5]); w.w = cvtpk(hv[6], hv[7]);
                *(u32x4*)(H + (size_t)row * DFF + col0) = w;
            }
    }
};
__device__ __forceinline__ int map_win(int n) {
    if (n < 1152) return n;
    if (n < 1158) return 3200 + (n - 1152);
    if (n < 1670) return Z_CV + (n - 1158);
    if (n < 2054) return Z_QH + (n - 1670);
    if (n < 2438) return 2816 + (n - 2054);
    if (n < 2822) return Z_IH + (n - 2438);
    return Z_GH + (n - 2822);
}
template <int MODE>
__device__ __forceinline__ void transpose_item(const float* W, int K, int N, bf16_t* WT, const float* gs, LAS float* scr, int item, int lane) {
    const int nblk = (N + 31) / 32, kb = item / nblk, nb = item % nblk, k0 = 64 * kb, n0 = 32 * nb;
    const int nn = n0 + (lane & 31);
#pragma unroll 8
    for (int i = 0; i < 32; ++i) { const int kk = 2 * i + (lane >> 5); float v = (nn < N) ? W[(size_t)(k0 + kk) * N + nn] : 0.f; if (gs) v *= gs[k0 + kk]; scr[kk * 33 + (lane & 31)] = v; }
    asm volatile("s_waitcnt lgkmcnt(0)" ::: "memory");
    const int c = lane & 7;
#pragma unroll
    for (int j = 0; j < 4; ++j) {
        const int nl = (lane >> 3) + 8 * j, n = n0 + nl; const LAS float* s = scr + (8 * c) * 33 + nl;
        if (n < N) {
            int row; float sc = 1.f;
            if (MODE == 0) { row = map_win(n); if (n < 384) sc = QSCALE; }
            else if (MODE == 2) { row = (n < DFF) ? ((n >> 7) * 256 + (n & 127)) : ((((n - DFF) >> 7) * 256) + 128 + ((n - DFF) & 127)); }
            else row = n;
            u32x4 o; o.x = cvtpk(s[0 * 33] * sc, s[1 * 33] * sc); o.y = cvtpk(s[2 * 33] * sc, s[3 * 33] * sc); o.z = cvtpk(s[4 * 33] * sc, s[5 * 33] * sc); o.w = cvtpk(s[6 * 33] * sc, s[7 * 33] * sc);
            *(u32x4*)(WT + (size_t)row * K + k0 + 8 * c) = o;
        }
    }
    asm volatile("s_waitcnt lgkmcnt(0)" ::: "memory");
}
__device__ __forceinline__ void prologue(const Args& a, LAS unsigned char* lds, int G, int bx) {
    const int tid = opaque_tid(), lane = tid & 63, wid = __builtin_amdgcn_readfirstlane(tid >> 6), gw = bx * 8 + wid, NGW = G * 8;
    LAS float* scr = (LAS float*)(lds + wid * 16384);
    constexpr int I_IN = 16 * 101, I_OUT = 16 * 32, I_FI = 16 * 176, I_FO = 44 * 32, I_L = I_IN + I_OUT + I_FI + I_FO;
    for (int it = gw; it < DEPTH * I_L; it += NGW) {
        const int l = it / I_L; int r = it % I_L;
        if (r < I_IN) { transpose_item<0>(a.w_in + (size_t)l * D * DIN, D, DIN, (bf16_t*)(a.ws + WS_WIN) + (size_t)l * NIN * D, a.norm_mix_g + l * D, scr, r, lane); continue; } r -= I_IN;
        if (r < I_OUT) { transpose_item<1>(a.w_out + (size_t)l * D * D, D, D, (bf16_t*)(a.ws + WS_WOUT) + (size_t)l * D * D, nullptr, scr, r, lane); continue; } r -= I_OUT;
        if (r < I_FI) { transpose_item<2>(a.w_ffn_in + (size_t)l * D * NFF, D, NFF, (bf16_t*)(a.ws + WS_WFI) + (size_t)l * NFF * D, a.norm_ffn_g + l * D, scr, r, lane); continue; } r -= I_FI;
        transpose_item<1>(a.w_ffn_out + (size_t)l * DFF * D, DFF, D, (bf16_t*)(a.ws + WS_WFO) + (size_t)l * D * DFF, nullptr, scr, r, lane);
    }
    bf16_t* xb = (bf16_t*)(a.ws + WS_XB); float* ssq = (float*)(a.ws + WS_SSQ);
    for (int m = gw; m < M; m += NGW) {
        const f32x4* xr = (const f32x4*)(a.x + (size_t)m * D) + lane; float s = 0.f;
        u32x2* o8 = (u32x2*)(xb + (size_t)m * D) + lane;
#pragma unroll
        for (int j = 0; j < 4; ++j) { const f32x4 v = xr[64 * j]; s += (v[0] * v[0] + v[1] * v[1]) + (v[2] * v[2] + v[3] * v[3]); u32x2 w; w.x = cvtpk(v[0], v[1]); w.y = cvtpk(v[2], v[3]); o8[64 * j] = w; }
        s = wave_sum(s);
        if (lane < 16) ssq[(size_t)m * 16 + lane] = (lane == 0) ? s : 0.f;
    }
}
__device__ __forceinline__ void final_norm(const Args& a, int G, int bx) {
    const int tid = opaque_tid(), lane = tid & 63, wid = __builtin_amdgcn_readfirstlane(tid >> 6), gw = bx * 8 + wid, NGW = G * 8;
    for (int m = gw; m < M; m += NGW) {
        f32x4* xr = (f32x4*)(a.out + (size_t)m * D) + lane; const f32x4* gr = (const f32x4*)a.norm_final_g + lane;
        f32x4 v[4]; float s = 0.f;
#pragma unroll
        for (int j = 0; j < 4; ++j) { v[j] = xr[64 * j]; s += (v[j][0] * v[j][0] + v[j][1] * v[j][1]) + (v[j][2] * v[j][2] + v[j][3] * v[j][3]); }
        const float rs = rsqrtf(wave_sum(s) * (1.f / D) + 1e-6f);
#pragma unroll
        for (int j = 0; j < 4; ++j) xr[64 * j] = v[j] * rs * gr[64 * j];
    }
}

__device__ __forceinline__ void attn_prep(LAS unsigned char* L, const bf16_t* Z, const float* ZF, const float* fgb, float* cs, float* kpm, int bh) {
    const int tid = opaque_tid(), lane = tid & 63, wid = tid >> 6, b = bh / 6, h = bh % 6;
    LAS float* wtot = (LAS float*)L;
    LAS float* tm = (LAS float*)(L + 64);
    LAS float* tl = (LAS float*)(L + 64 + 2048);
    const float fb = fgb[h];
    float lf[16]; float s = 0.f;
    const size_t r0 = (size_t)b * T + 16 * tid;
#pragma unroll
    for (int i = 0; i < 16; ++i) { const float x = ZF[(r0 + i) * ZFP + ZF_FA + h] + fb; lf[i] = fminf(x, 0.f) - log1pf(__expf(-fabsf(x))); s += lf[i]; }
    float inc = s;
#pragma unroll
    for (int o = 1; o < 64; o <<= 1) { const float t = __shfl_up(inc, o); if (lane >= o) inc += t; }
    if (lane == 63) wtot[wid] = inc;
    float mx = 0.f;
#pragma unroll 4
    for (int i = 0; i < 16; ++i) {
        const u32x4* kp = (const u32x4*)(Z + (r0 + i) * ZP + Z_KA + h * 64); float n2 = 0.f;
#pragma unroll
        for (int c = 0; c < 8; ++c) { const u32x4 w = kp[c];
#pragma unroll
            for (int e = 0; e < 4; ++e) { const float lo = bflo(w[e]), hi = bfhi(w[e]); n2 += lo * lo + hi * hi; } }
        mx = fmaxf(mx, n2);
    }
    tm[tid] = mx;
    __syncthreads();
    float run = inc - s;
    for (int w = 0; w < wid; ++w) run += wtot[w];
#pragma unroll
    for (int i = 0; i < 16; ++i) { run += lf[i]; cs[(size_t)bh * T + 16 * tid + i] = run; }
    if (tid < 128) tl[tid] = fmaxf(fmaxf(tm[4 * tid], tm[4 * tid + 1]), fmaxf(tm[4 * tid + 2], tm[4 * tid + 3]));
    __syncthreads();
    if (tid < 128) { float p = 0.f; for (int i = 0; i <= tid; ++i) p = fmaxf(p, tl[i]); kpm[bh * 128 + tid] = p; }
    __syncthreads();
}

constexpr int AK_STR = 144, AV_STR = 192, AK_BYTES = 64 * AK_STR, AV_BYTES = 64 * AV_STR, A_VOFF = 2 * AK_BYTES, A_BOFF = A_VOFF + 2 * AV_BYTES, A_VOTE = A_BOFF + 512;
__device__ __forceinline__ void attn_unit(LAS unsigned char* L, const bf16_t* Z, const float* cs, const float* kpm, bf16_t* MIX, int bh, int qb) {
    const int tid = opaque_tid(), lane = tid & 63, r32 = lane & 31, hi = lane >> 5; const int wid = __builtin_amdgcn_readfirstlane(tid >> 6);
    const int b = bh / 6, h = bh % 6; const size_t rowbase = (size_t)b * T; const int q0 = qb * 256, t0 = q0 + wid * 32;
    bf16x8 qr[4];
    { const bf16_t* Qp = Z + (rowbase + t0 + r32) * ZP + Z_QA + h * 64 + hi * 8;
#pragma unroll
      for (int d0 = 0; d0 < 4; ++d0) qr[d0] = *(const bf16x8*)(Qp + d0 * 16); }
    float qn2 = 0.f;
#pragma unroll
    for (int d0 = 0; d0 < 4; ++d0)
#pragma unroll
        for (int e = 0; e < 8; ++e) { const float v = bf2f((unsigned short)qr[d0][e]); qn2 += v * v; }
    qn2 += __shfl_xor(qn2, 32);
    const float qn = sqrtf(qn2) * 1.001f;
    const float* csb = cs + (size_t)bh * T; const float cref = csb[q0];
    const int srow = tid >> 3, sch = tid & 7;
    const bf16_t* Kg = Z + rowbase * ZP + Z_KA + h * 64 + sch * 8; const bf16_t* Vg = Z + rowbase * ZP + Z_VA + h * 64 + sch * 8;
    int j = (q0 + 256) / 64 - 1;
    u32x4 kreg = *(const u32x4*)(Kg + (size_t)(64 * j + srow) * ZP), vreg = *(const u32x4*)(Vg + (size_t)(64 * j + srow) * ZP);
    float cval = (tid < 64) ? csb[64 * j + tid] : 0.f;
    *(LAS u32x4*)(L + srow * AK_STR + sch * 16) = kreg; *(LAS u32x4*)(L + A_VOFF + srow * AV_STR + sch * 16) = vreg;
    if (tid < 64) ((LAS float*)(L + A_BOFF))[tid] = (cref - cval) * LOG2E;
    __syncthreads();
    float m = -1e30f, l = 0.f; f32x16 o[2]; o[0] = f32x16{}; o[1] = f32x16{};
    int buf = 0;
    const int tq = (lane & 15) >> 2, tp = lane & 3, tg1 = (lane >> 4) & 1;
    for (;;) {
        const bool more = j > 0;
        if (more) { kreg = *(const u32x4*)(Kg + (size_t)(64 * (j - 1) + srow) * ZP); vreg = *(const u32x4*)(Vg + (size_t)(64 * (j - 1) + srow) * ZP); cval = (tid < 64) ? csb[64 * (j - 1) + tid] : 0.f; }
        const int k0 = 64 * j;
        if (k0 <= t0 + 31) {
            const LAS unsigned char* Kb = L + buf * AK_BYTES; const LAS unsigned char* Vb = L + A_VOFF + buf * AV_BYTES;
            const LAS float* kbp = (const LAS float*)(L + A_BOFF + buf * 256) + 4 * hi;
            f32x16 p0, p1;
#pragma unroll
            for (int i = 0; i < 4; ++i) { const f32x4 ta = *(const LAS f32x4*)(kbp + 8 * i), tb = *(const LAS f32x4*)(kbp + 32 + 8 * i);
#pragma unroll
                for (int e = 0; e < 4; ++e) { p0[4 * i + e] = ta[e]; p1[4 * i + e] = tb[e]; } }
#pragma unroll
            for (int d0 = 0; d0 < 4; ++d0) {
                const bf16x8 a0 = *(const LAS bf16x8*)(Kb + r32 * AK_STR + d0 * 32 + hi * 16), a1 = *(const LAS bf16x8*)(Kb + (32 + r32) * AK_STR + d0 * 32 + hi * 16);
                p0 = __builtin_amdgcn_mfma_f32_32x32x16_bf16(a0, qr[d0], p0, 0, 0, 0); p1 = __builtin_amdgcn_mfma_f32_32x32x16_bf16(a1, qr[d0], p1, 0, 0, 0);
            }
            if (k0 + 63 > t0) { const int tt = t0 + r32;
#pragma unroll
                for (int r = 0; r < 16; ++r) { const int kv = k0 + crow(r, hi); if (kv > tt) p0[r] = -INFINITY; if (kv + 32 > tt) p1[r] = -INFINITY; } }
            float mx = fmaxf(p0[0], p1[0]);
#pragma unroll
            for (int r = 1; r < 16; ++r) mx = fmaxf(mx, fmaxf(p0[r], p1[r]));
            mx = fmaxf(mx, __shfl_xor(mx, 32));
            const float mnew = fmaxf(m, mx), alpha = __builtin_amdgcn_exp2f(m - mnew);
            float sum = 0.f;
#pragma unroll
            for (int r = 0; r < 16; ++r) { p0[r] = __builtin_amdgcn_exp2f(p0[r] - mnew); p1[r] = __builtin_amdgcn_exp2f(p1[r] - mnew); sum += p0[r] + p1[r]; }
            l = l * alpha + sum; m = mnew;
#pragma unroll
            for (int r = 0; r < 16; ++r) { o[0][r] *= alpha; o[1][r] *= alpha; }
            u32x4 pw[4];
#pragma unroll
            for (int e = 0; e < 4; ++e) { pw[0][e] = cvtpk(p0[2 * e], p0[2 * e + 1]); pw[1][e] = cvtpk(p0[8 + 2 * e], p0[9 + 2 * e]); pw[2][e] = cvtpk(p1[2 * e], p1[2 * e + 1]); pw[3][e] = cvtpk(p1[8 + 2 * e], p1[9 + 2 * e]); }
#pragma unroll
            for (int dh = 0; dh < 2; ++dh)
#pragma unroll
                for (int s = 0; s < 4; ++s) {
                    const LAS unsigned char* ap = Vb + (16 * s + 4 * hi + tq) * AV_STR + (32 * dh + 16 * tg1 + 4 * tp) * 2;
                    const bf16x8 vf = cat8(trread(ap), trread(ap + 8 * AV_STR));
                    o[dh] = __builtin_amdgcn_mfma_f32_32x32x16_bf16(vf, __builtin_bit_cast(bf16x8, pw[s]), o[dh], 0, 0, 0);
                }
        }
        if (more) {
            const int nb = buf ^ 1;
            *(LAS u32x4*)(L + nb * AK_BYTES + srow * AK_STR + sch * 16) = kreg; *(LAS u32x4*)(L + A_VOFF + nb * AV_BYTES + srow * AV_STR + sch * 16) = vreg;
            if (tid < 64) ((LAS float*)(L + A_BOFF + nb * 256))[tid] = (cref - cval) * LOG2E;
            const float kmax = sqrtf(kpm[bh * 128 + j - 1]) * 1.001f, bmax = (cref - csb[64 * (j - 1) + 63]) * LOG2E;
            const int vote = __all((qn * kmax + bmax - m) < -170.f);
            if (lane == 0) ((LAS int*)(L + A_VOTE + nb * 32))[wid] = vote;
        }
        __syncthreads();
        if (!more) break;
        { const LAS int* vp = (const LAS int*)(L + A_VOTE + (buf ^ 1) * 32); int all = 1;
#pragma unroll
          for (int w = 0; w < 8; ++w) all &= vp[w];
          if (all) break; }
        --j; buf ^= 1;
    }
    l += __shfl_xor(l, 32);
    const float inv = 1.0f / l;
    bf16_t* Op = MIX + (rowbase + t0 + r32) * D + MIX_ATT + h * 64;
#pragma unroll
    for (int dh = 0; dh < 2; ++dh)
#pragma unroll
        for (int g = 0; g < 4; ++g) { u32x2 w; w.x = cvtpk(o[dh][4 * g] * inv, o[dh][4 * g + 1] * inv); w.y = cvtpk(o[dh][4 * g + 2] * inv, o[dh][4 * g + 3] * inv); *(u32x2*)(Op + 32 * dh + 8 * g + 4 * hi) = w; }
    __syncthreads();
}

__device__ __forceinline__ void conv_item(LAS unsigned char* L, const bf16_t* Z, const float* cw, const float* cb, const float* lg, const float* lb, bf16_t* MIX, int item) {
    const int tid = opaque_tid(), lane = tid & 63, wid = tid >> 6; const int b = item >> 8, t0 = (item & 255) * 32; const size_t rowbase = (size_t)b * T;
    LAS float* hs = (LAS float*)L;
    LAS float* ob = (LAS float*)(L + 62 * 1024);
    for (int ci = tid; ci < 62 * 32; ci += 512) {
        const int r = ci >> 5, ch = ci & 31, t = t0 - 30 + r; f32x4 h0 = {0.f, 0.f, 0.f, 0.f}, h1 = h0;
        if (t >= 0) { const bf16_t* p = Z + (rowbase + t) * ZP + Z_CV + ch * 8; const u32x4 av = *(const u32x4*)p, gv = *(const u32x4*)(p + 256);
#pragma unroll
            for (int e = 0; e < 2; ++e) { h0[2 * e] = bflo(av[e]) * sigmoidf_(bflo(gv[e])); h0[2 * e + 1] = bfhi(av[e]) * sigmoidf_(bfhi(gv[e])); h1[2 * e] = bflo(av[2 + e]) * sigmoidf_(bflo(gv[2 + e])); h1[2 * e + 1] = bfhi(av[2 + e]) * sigmoidf_(bfhi(gv[2 + e])); } }
        *(LAS f32x4*)(hs + r * 256 + ch * 8) = h0; *(LAS f32x4*)(hs + r * 256 + ch * 8 + 4) = h1;
    }
    __syncthreads();
    { const int c = tid & 255, half = tid >> 8; float w[31];
#pragma unroll
      for (int jj = 0; jj < 31; ++jj) w[jj] = cw[jj * 256 + c];
      const float bias = cb[c];
      for (int tt = 0; tt < 16; ++tt) { const int tl = 16 * half + tt; float acc = bias;
#pragma unroll
          for (int jj = 0; jj < 31; ++jj) acc += w[jj] * hs[(tl + jj) * 256 + c];
          ob[tl * 256 + c] = acc; } }
    __syncthreads();
    { const f32x4 g4 = *(const f32x4*)(lg + 4 * lane), b4 = *(const f32x4*)(lb + 4 * lane);
#pragma unroll
      for (int k = 0; k < 4; ++k) { const int tl = 4 * wid + k; const f32x4 v = *(const LAS f32x4*)(ob + tl * 256 + 4 * lane);
          const float mu = wave_sum((v[0] + v[1]) + (v[2] + v[3])) * (1.f / 256.f); const f32x4 d = v - mu;
          const float var = wave_sum((d[0] * d[0] + d[1] * d[1]) + (d[2] * d[2] + d[3] * d[3])) * (1.f / 256.f); const float rs = rsqrtf(var + 1e-5f);
          const f32x4 y = d * rs * g4 + b4; u32x2 w; w.x = cvtpk(siluf_(y[0]), siluf_(y[1])); w.y = cvtpk(siluf_(y[2]), siluf_(y[3]));
          *(u32x2*)(MIX + (rowbase + t0 + tl) * D + MIX_CNV + 4 * lane) = w; } }
    __syncthreads();
}
__device__ __forceinline__ void hgrn_load_v(LAS unsigned char* vimg, const bf16_t* Z, size_t R0, int hh, int lane) {
#pragma unroll
    for (int it = 0; it < 8; ++it) { const int idx = it * 64 + lane, row = idx >> 3, ch = idx & 7; *(LAS u32x4*)(vimg + row * 128 + ch * 16) = *(const u32x4*)(Z + (R0 + row) * ZP + Z_IH + hh * 64 + ch * 8); }
}
__device__ __forceinline__ void hgrn_elem(float z, float lb, float oml, float& kk, float& g) {
    const float ez = __expf(-fabsf(z)), r = fast_rcp(1.f + ez), sp = r, sn = ez * r;
    const float sg = z >= 0.f ? sp : sn, oms = z >= 0.f ? sn : sp;
    const float f = fmaxf(lb + oml * sg, 1e-30f); kk = oml * oms; g = __logf(f);
}
__device__ __forceinline__ void hgrn_a(LAS unsigned char* Lw, bf16_t* Z, const float* ZF, bf16_t* KT, const float* lbl, int layer, float* UT, float* EM, float* EE, int item, int lane) {
    const int c = item & 127, bhh = item >> 7, hh = bhh % 6, b = bhh / 6;
    const size_t R0 = (size_t)b * T + 64 * c; const int col = hh * 64 + lane;
    float lb;
    { float lg[4], mx = -1e30f;
#pragma unroll
      for (int i = 0; i < 4; ++i) { lg[i] = lbl[i * 384 + col]; mx = fmaxf(mx, lg[i]); }
      float se = 0.f, num = 0.f;
#pragma unroll
      for (int i = 0; i < 4; ++i) { const float e = __expf(lg[i] - mx); se += e; if (i >= 1 && i <= layer) num += e; }
      lb = num / se; }
    const float oml = 1.f - lb;
    LAS unsigned char* kimg = Lw; LAS unsigned char* vimg = Lw + 8192;
    hgrn_load_v(vimg, Z, R0, hh, lane);
    float nb = 0.f;
#pragma unroll 1
    for (int bt = 0; bt < 2; ++bt) {
        const int base = 16 - 16 * bt; float zv[16]; unsigned short qv[16];
#pragma unroll
        for (int i = 0; i < 16; ++i) { zv[i] = ZF[(R0 + base + i) * ZFP + ZF_FH + col]; qv[i] = Z[(R0 + base + i) * ZP + Z_QH + col]; }
#pragma unroll
        for (int i = 15; i >= 0; --i) { const int t = base + i; float kk, g; hgrn_elem(zv[i], lb, oml, kk, g);
            const unsigned short qt = f2bf(bf2f(qv[i]) * __expf(-nb)), kt = f2bf(kk * __expf(nb));
            Z[(R0 + t) * ZP + Z_QH + col] = qt; KT[(R0 + t) * 384 + col] = kt; *(LAS unsigned short*)(kimg + t * 128 + lane * 2) = kt; nb += g; }
    }
    float fa = 0.f;
#pragma unroll 1
    for (int bt = 0; bt < 2; ++bt) {
        const int base = 32 + 16 * bt; float zv[16]; unsigned short qv[16];
#pragma unroll
        for (int i = 0; i < 16; ++i) { zv[i] = ZF[(R0 + base + i) * ZFP + ZF_FH + col]; qv[i] = Z[(R0 + base + i) * ZP + Z_QH + col]; }
#pragma unroll
        for (int i = 0; i < 16; ++i) { const int t = base + i; float kk, g; hgrn_elem(zv[i], lb, oml, kk, g); fa += g;
            const unsigned short qt = f2bf(bf2f(qv[i]) * __expf(fa)), kt = f2bf(kk * __expf(-fa));
            Z[(R0 + t) * ZP + Z_QH + col] = qt; KT[(R0 + t) * 384 + col] = kt; *(LAS unsigned short*)(kimg + t * 128 + lane * 2) = kt; }
    }
    EM[(size_t)item * 64 + lane] = __expf(nb); EE[(size_t)item * 64 + lane] = __expf(nb + fa);
    const float usc = __expf(fa);
    asm volatile("s_waitcnt lgkmcnt(0)" ::: "memory");
    const int tq = (lane & 15) >> 2, tp = lane & 3, tg1 = (lane >> 4) & 1, hi = lane >> 5, r32 = lane & 31;
#pragma unroll
    for (int vh = 0; vh < 2; ++vh)
#pragma unroll
        for (int dh = 0; dh < 2; ++dh) {
            f32x16 acc = f32x16{};
#pragma unroll
            for (int st = 0; st < 4; ++st) {
                const LAS unsigned char* ap = vimg + (16 * st + 8 * hi + tq) * 128 + (32 * vh + 16 * tg1 + 4 * tp) * 2;
                const LAS unsigned char* bp = kimg + (16 * st + 8 * hi + tq) * 128 + (32 * dh + 16 * tg1 + 4 * tp) * 2;
                acc = __builtin_amdgcn_mfma_f32_32x32x16_bf16(cat8(trread(ap), trread(ap + 4 * 128)), cat8(trread(bp), trread(bp + 4 * 128)), acc, 0, 0, 0);
            }
            const float sc = __shfl(usc, 32 * dh + r32);
#pragma unroll
            for (int r = 0; r < 16; ++r) UT[(size_t)item * 4096 + (32 * vh + crow(r, hi)) * 64 + 32 * dh + r32] = acc[r] * sc;
        }
    asm volatile("s_waitcnt lgkmcnt(0)" ::: "memory");
}
__device__ __forceinline__ void hgrn_scan(const float* UT, const float* EM, const float* EE, bf16_t* SP, int item) {
    const int bhh = item >> 3, seg = item & 7, e = seg * 512 + opaque_tid(), dk = e & 63;
    float S = 0.f;
#pragma unroll 1
    for (int c0 = 0; c0 < 128; c0 += 8) {
        float u[8], em[8], ee[8];
#pragma unroll
        for (int i = 0; i < 8; ++i) { const size_t it = (size_t)bhh * 128 + c0 + i; u[i] = UT[it * 4096 + e]; em[i] = EM[it * 64 + dk]; ee[i] = EE[it * 64 + dk]; }
#pragma unroll
        for (int i = 0; i < 8; ++i) { const size_t it = (size_t)bhh * 128 + c0 + i; SP[it * 4096 + e] = f2bf(em[i] * S); S = ee[i] * S + u[i]; }
    }
}
__device__ __forceinline__ void hgrn_o(LAS unsigned char* Lw, const bf16_t* Z, const bf16_t* KT, const bf16_t* SP, const float* ng, bf16_t* MIX, int item, int lane) {
    const int c = item & 127, bhh = item >> 7, hh = bhh % 6, b = bhh / 6;
    const size_t R0 = (size_t)b * T + 64 * c;
    const int tq = (lane & 15) >> 2, tp = lane & 3, tg1 = (lane >> 4) & 1, hi = lane >> 5, r32 = lane & 31;
    LAS unsigned char* vimg = Lw;
    hgrn_load_v(vimg, Z, R0, hh, lane);
    asm volatile("s_waitcnt lgkmcnt(0)" ::: "memory");
#pragma unroll 1
    for (int tau = 0; tau < 2; ++tau) {
        bf16x8 qf[4];
        { const bf16_t* qp = Z + (R0 + 32 * tau + r32) * ZP + Z_QH + hh * 64 + 8 * hi;
#pragma unroll
          for (int st = 0; st < 4; ++st) qf[st] = *(const bf16x8*)(qp + 16 * st); }
        f32x16 X[2];
#pragma unroll
        for (int sh = 0; sh < 2; ++sh) { X[sh] = f32x16{}; const bf16_t* kp = KT + (R0 + 32 * sh + r32) * 384 + hh * 64 + 8 * hi;
#pragma unroll
            for (int st = 0; st < 4; ++st) X[sh] = __builtin_amdgcn_mfma_f32_32x32x16_bf16(*(const bf16x8*)(kp + 16 * st), qf[st], X[sh], 0, 0, 0); }
        const int t = 32 * tau + r32;
#pragma unroll
        for (int sh = 0; sh < 2; ++sh)
#pragma unroll
            for (int r = 0; r < 16; ++r) if (32 * sh + crow(r, hi) > t) X[sh][r] = 0.f;
        u32x4 pw[4];
#pragma unroll
        for (int e = 0; e < 4; ++e) { pw[0][e] = cvtpk(X[0][2 * e], X[0][2 * e + 1]); pw[1][e] = cvtpk(X[0][8 + 2 * e], X[0][9 + 2 * e]); pw[2][e] = cvtpk(X[1][2 * e], X[1][2 * e + 1]); pw[3][e] = cvtpk(X[1][8 + 2 * e], X[1][9 + 2 * e]); }
        f32x16 Y[2];
#pragma unroll
        for (int vh = 0; vh < 2; ++vh) { Y[vh] = f32x16{};
#pragma unroll
            for (int st = 0; st < 4; ++st) { const LAS unsigned char* ap = vimg + (16 * st + 4 * hi + tq) * 128 + (32 * vh + 16 * tg1 + 4 * tp) * 2;
                Y[vh] = __builtin_amdgcn_mfma_f32_32x32x16_bf16(cat8(trread(ap), trread(ap + 8 * 128)), __builtin_bit_cast(bf16x8, pw[st]), Y[vh], 0, 0, 0); }
            const bf16_t* sp = SP + ((size_t)item * 64 + 32 * vh + r32) * 64 + 8 * hi;
#pragma unroll
            for (int ds = 0; ds < 4; ++ds) Y[vh] = __builtin_amdgcn_mfma_f32_32x32x16_bf16(*(const bf16x8*)(sp + 16 * ds), qf[ds], Y[vh], 0, 0, 0); }
        float ss = 0.f;
#pragma unroll
        for (int r = 0; r < 16; ++r) ss += Y[0][r] * Y[0][r] + Y[1][r] * Y[1][r];
        ss += __shfl_xor(ss, 32);
        const float rs = rsqrtf(ss * (1.f / 64.f) + 1e-6f);
        const size_t R = R0 + t;
#pragma unroll
        for (int vh = 0; vh < 2; ++vh)
#pragma unroll
            for (int g4 = 0; g4 < 4; ++g4) { const int v0 = 32 * vh + 8 * g4 + 4 * hi;
                const u32x2 gw = *(const u32x2*)(Z + R * ZP + Z_GH + hh * 64 + v0); const f32x4 n4 = *(const f32x4*)(ng + v0);
                const float y0 = Y[vh][4 * g4] * rs * n4[0] * siluf_(bflo(gw.x)), y1 = Y[vh][4 * g4 + 1] * rs * n4[1] * siluf_(bfhi(gw.x));
                const float y2 = Y[vh][4 * g4 + 2] * rs * n4[2] * siluf_(bflo(gw.y)), y3 = Y[vh][4 * g4 + 3] * rs * n4[3] * siluf_(bfhi(gw.y));
                u32x2 w; w.x = cvtpk(y0, y1); w.y = cvtpk(y2, y3); *(u32x2*)(MIX + R * D + MIX_HG + hh * 64 + v0) = w; }
    }
    asm volatile("s_waitcnt lgkmcnt(0)" ::: "memory");
}

__global__ void __launch_bounds__(512, 2) fwd_megakernel(Args a) {
    extern __shared__ __attribute__((aligned(16))) unsigned char lds_raw[];
    cg::grid_group grid = cg::this_grid();
    LAS unsigned char* lds = (LAS unsigned char*)lds_raw;
    const int G = gridDim.x, bx = blockIdx.x;
    unsigned char* ws = a.ws;
    bf16_t* win_t = (bf16_t*)(ws + WS_WIN); bf16_t* wout_t = (bf16_t*)(ws + WS_WOUT); bf16_t* wfi_t = (bf16_t*)(ws + WS_WFI); bf16_t* wfo_t = (bf16_t*)(ws + WS_WFO);
    bf16_t* Z = (bf16_t*)(ws + WS_Z); bf16_t* H = Z; float* ZF = (float*)(ws + WS_ZF); bf16_t* SP = (bf16_t*)(ws + WS_ZF);
    bf16_t* XB = (bf16_t*)(ws + WS_XB); float* UT = (float*)(ws + WS_XB); bf16_t* MIX = (bf16_t*)(ws + WS_MIX); bf16_t* KT = (bf16_t*)(ws + WS_KT);
    float* SSQ = (float*)(ws + WS_SSQ); float* CS = (float*)(ws + WS_CS); float* KPM = (float*)(ws + WS_KPM); float* EM = (float*)(ws + WS_EM); float* EE = (float*)(ws + WS_EE);

#ifndef SKIP_P
    prologue(a, lds, G, bx);
#endif
    grid.sync();
#pragma unroll 1
    for (int l = 0; l < DEPTH; ++l) {
#ifndef SKIP_A
        { pg8::Gemm g{XB, win_t + (size_t)l * NIN * D, M, NIN, D}; pg8::StaticOrder S; S.init(M, NIN, G, bx); EpiIn E{Z, ZF, SSQ};
          pg8::gemm_phase<EpiIn, pg8::StaticOrder, true, true>(lds, g, S, E); }
#endif
        grid.sync();
#ifndef SKIP_B
        for (int it = bx; it < 24 + 1024; it += G) {
            if (it < 24) attn_prep(lds, Z, ZF, a.fgate_b + l * 6, CS, KPM, it);
            else conv_item(lds, Z, a.conv_w + (size_t)l * 31 * 256, a.conv_b + l * 256, a.conv_ln_g + l * 256, a.conv_ln_b + l * 256, MIX, it - 24);
        }
        __syncthreads();
        { const int tid = opaque_tid(), lane = tid & 63, wid = __builtin_amdgcn_readfirstlane(tid >> 6);
          for (int it = bx * 8 + wid; it < NHITEM; it += G * 8) hgrn_a(lds + wid * 16384, Z, ZF, KT, a.lb_logits, l, UT, EM, EE, it, lane); }
#endif
        grid.sync();
#ifndef SKIP_C
        for (int it = bx; it < 192; it += G) hgrn_scan(UT, EM, EE, SP, it);
        for (int i = 0;; ++i) {
            const int pos = i * G + ((i & 1) ? (G - 1 - bx) : bx); if (pos >= 768) break;
            attn_unit(lds, Z, CS, KPM, MIX, pos % 24, 31 - pos / 24);
        }
#endif
        grid.sync();
#ifndef SKIP_D
        { const int tid = opaque_tid(), lane = tid & 63, wid = __builtin_amdgcn_readfirstlane(tid >> 6);
          for (int it = bx * 8 + wid; it < NHITEM; it += G * 8) hgrn_o(lds + wid * 16384, Z, KT, SP, a.hgrn_norm_g + l * 64, MIX, it, lane); }
#endif
        grid.sync();
#ifndef SKIP_E
        { pg8::Gemm g{MIX, wout_t + (size_t)l * D * D, M, D, D}; pg8::StaticOrder S; S.init(M, D, G, bx); EpiRes E{l == 0 ? a.x : a.out, a.out, XB, SSQ};
          pg8::gemm_phase<EpiRes, pg8::StaticOrder, true, true>(lds, g, S, E); }
#endif
        grid.sync();
#ifndef SKIP_F
        { pg8::Gemm g{XB, wfi_t + (size_t)l * NFF * D, M, NFF, D}; pg8::StaticOrder S; S.init(M, NFF, G, bx); EpiGlu E{H, SSQ};
          pg8::gemm_phase<EpiGlu, pg8::StaticOrder, true, true>(lds, g, S, E); }
#endif
        grid.sync();
#ifndef SKIP_G
        { pg8::Gemm g{H, wfo_t + (size_t)l * D * DFF, M, D, DFF}; pg8::StaticOrder S; S.init(M, D, G, bx); EpiRes E{a.out, a.out, XB, SSQ};
          pg8::gemm_phase<EpiRes, pg8::StaticOrder, true, true>(lds, g, S, E); }
#endif
        grid.sync();
    }
#ifndef SKIP_N
    final_norm(a, G, bx);
#endif
}

extern "C" void kernel_launch(void* const* d_in, const int* in_sizes, int n_in, void* d_out, int out_size, void* d_ws, size_t ws_size, hipStream_t stream) {
    static int grid = 0;
    if (grid == 0) {
        if (n_in != 15 || out_size != M * D || ws_size < WS_END) { fprintf(stderr, "kernel_launch: unexpected problem (n_in %d out %d ws %zu)\n", n_in, out_size, ws_size); grid = -1; return; }
        int dev = 0, cus = 0, per = 0;
        hipGetDevice(&dev); hipDeviceGetAttribute(&cus, hipDeviceAttributeMultiprocessorCount, dev);
        hipFuncSetAttribute((const void*)fwd_megakernel, hipFuncAttributeMaxDynamicSharedMemorySize, LDS_BYTES);
        if (hipOccupancyMaxActiveBlocksPerMultiprocessor(&per, (const void*)fwd_megakernel, 512, LDS_BYTES) != hipSuccess || per < 1) { fprintf(stderr, "kernel_launch: occupancy query gave %d\n", per); per = 1; }
        (void)hipGetLastError();
        grid = cus * per;
        fprintf(stderr, "kernel_launch: grid %d (cus %d x %d), ws %zu\n", grid, cus, per, ws_size);
    }
    if (grid < 0) return;
    Args a{};
    a.x = (const float*)d_in[0]; a.norm_mix_g = (const float*)d_in[1]; a.w_in = (const float*)d_in[2]; a.fgate_b = (const float*)d_in[3]; a.conv_w = (const float*)d_in[4];
    a.conv_b = (const float*)d_in[5]; a.conv_ln_g = (const float*)d_in[6]; a.conv_ln_b = (const float*)d_in[7]; a.lb_logits = (const float*)d_in[8]; a.hgrn_norm_g = (const float*)d_in[9];
    a.w_out = (const float*)d_in[10]; a.norm_ffn_g = (const float*)d_in[11]; a.w_ffn_in = (const float*)d_in[12]; a.w_ffn_out = (const float*)d_in[13]; a.norm_final_g = (const float*)d_in[14];
    a.out = (float*)d_out; a.ws = (unsigned char*)d_ws;
    void* args[] = {&a};
    hipError_t e = hipLaunchCooperativeKernel((const void*)fwd_megakernel, dim3(grid), dim3(512), args, LDS_BYTES, stream);
    if (e != hipSuccess) fprintf(stderr, "kernel_launch: cooperative launch failed: %s (grid %d)\n", hipGetErrorString(e), grid);
}
```

```cpp
#include <hip/hip_runtime.h>
#include <hip/hip_cooperative_groups.h>
#include <cstdio>
#include <cstdint>
namespace cg = cooperative_groups;
__device__ __forceinline__ int opaque_tid() { int t = threadIdx.x; asm volatile("" : "+v"(t)); return t; }
namespace pg8 {
#define PG8_LAS __attribute__((address_space(3)))
typedef unsigned short bf16_t;
typedef short bf16x8 __attribute__((ext_vector_type(8)));
typedef float f32x4 __attribute__((ext_vector_type(4)));
typedef unsigned u32x4 __attribute__((ext_vector_type(4)));
constexpr int BM = 256, BK = 64, HALF = 128, HTB = HALF * BK * 2  , STAGE_BYTES = 8 * HTB, NXCD = 8, WGM = 8;

__host__ __device__ __forceinline__ int lds_byte(int r, int c) { const int st = (r >> 4) * 2 + (c >> 5), rr = r & 15, cc = c & 31, ob = rr * 64 + cc * 2; return st * 1024 + (ob ^ (((ob >> 9) & 1) << 5)); }
__host__ __device__ __forceinline__ void stage_rc(int b, int& R, int& C) { const int st = b / 1024, sb = b % 1024, swz = sb ^ (((sb >> 9) & 1) << 5); R = (st >> 1) * 16 + swz / 64; C = (st & 1) * 32 + (swz % 64) / 2; }
__host__ __device__ __forceinline__ int perm32(int rho) { const int n = rho >> 4, i = rho & 15; return 8 * (i >> 2) + 4 * n + (i & 3); }

struct Unit { int pm, pn; };
struct Gemm { const bf16_t* A; const bf16_t* Bt; int M, N, K; };

struct StaticOrder {
    int nM, nN, nwg, G, c;
    __host__ __device__ void init(int M, int N, int G_, int c_) { nM = M / BM; nN = N / BM; nwg = nM * nN; G = G_; c = c_; }
    __host__ __device__ bool next(int i, Unit& u) const {
        const long L = (long)i * G + c; if (L >= nwg) return false;
        int wgid = (int)L; { const int q = nwg / NXCD, r = nwg % NXCD, xcd = wgid % NXCD, off = wgid / NXCD; wgid = (xcd < r ? xcd * (q + 1) : r * (q + 1) + (xcd - r) * q) + off; }
        const int nig = WGM * nN, gid = wgid / nig, fm = gid * WGM, gsz = (nM - fm) < WGM ? (nM - fm) : WGM;
        u.pm = fm + ((wgid % nig) % gsz); u.pn = (wgid % nig) / gsz; return true;
    }
    __device__ __forceinline__ void a_ready(const Unit&) const {}
    __device__ __forceinline__ void done(const Unit&) const {}
};

__device__ __forceinline__ unsigned cvt_pk_bf16(float lo, float hi) { unsigned r; asm volatile("v_cvt_pk_bf16_f32 %0, %1, %2" : "=v"(r) : "v"(lo), "v"(hi)); return r; }
typedef float f32x2 __attribute__((ext_vector_type(2)));
template <class Epi, class Sched, bool ALIGN_EPI = false, bool SP2 = false>
__device__ __forceinline__ void gemm_phase(PG8_LAS unsigned char* lds, const Gemm g, const Sched& S, const Epi& E) {
    const int tid = opaque_tid(), wid = __builtin_amdgcn_readfirstlane(tid >> 6), lane = tid & 63, wr = wid >> 2, wc = wid & 3, fr = lane & 15, fq = lane >> 4;
    const int K = g.K, nt = K / BK;
    unsigned voffA[2], voffB[2];
#pragma unroll
    for (int i = 0; i < 2; ++i) { int R, C; stage_rc(tid * 16 + i * 8192, R, C); const int Rb = Epi::PERM ? ((R & ~31) + perm32(R & 31)) : R;
        voffA[i] = (unsigned)(R * K + C) * 2u; voffB[i] = (unsigned)(Rb * K + C) * 2u; }
    const size_t kstep = (size_t)(BK * 2);
    const size_t hstep = (size_t)HALF * K * 2;
    const size_t tstep = 2 * hstep;
    const unsigned ldsw = (unsigned)wid * 1024u;
    const int aoff = lds_byte(wr * 64 + fr, fq * 8), boff = lds_byte(wc * 32 + fr, fq * 8);
#define PG8_SA(b, h) (((b) * 2 + (h)) * HTB)
#define PG8_SB(b, h) ((4 + (b) * 2 + (h)) * HTB)
#define PG8_STAGE(bufoff, gbase, voff) do { _Pragma("unroll") for (int _i = 0; _i < 2; ++_i) \
        __builtin_amdgcn_global_load_lds((const unsigned*)((const char*)(gbase) + (voff)[_i]), (PG8_LAS unsigned*)(lds + (bufoff) + ldsw + _i * 8192), 16, 0, 0); } while (0)
#define PG8_LDA(dst, b, h) do { _Pragma("unroll") for (int m = 0; m < 4; ++m) _Pragma("unroll") for (int k = 0; k < 2; ++k) dst[m][k] = *(const PG8_LAS bf16x8*)(lds + PG8_SA(b, h) + aoff + m * 2048 + k * 1024); } while (0)
#define PG8_LDB(dst, b, h) do { _Pragma("unroll") for (int n = 0; n < 2; ++n) _Pragma("unroll") for (int k = 0; k < 2; ++k) dst[n][k] = *(const PG8_LAS bf16x8*)(lds + PG8_SB(b, h) + boff + n * 2048 + k * 1024); } while (0)
#define PG8_MMA(ai, bj, At, Bt) do { __builtin_amdgcn_s_setprio(1); _Pragma("unroll") for (int m = 0; m < 4; ++m) _Pragma("unroll") for (int n = 0; n < 2; ++n) _Pragma("unroll") for (int k = 0; k < 2; ++k) \
        acc[ai][bj][m][n] = __builtin_amdgcn_mfma_f32_16x16x32_bf16(Bt[n][k], At[m][k], acc[ai][bj][m][n], 0, 0, 0); __builtin_amdgcn_s_setprio(0); } while (0)
#define PG8_WAIT_V(n) asm volatile("s_waitcnt vmcnt(" #n ")" ::: "memory")
#define PG8_WAIT_L(n) asm volatile("s_waitcnt lgkmcnt(" #n ")" ::: "memory")
#define PG8_BAR __builtin_amdgcn_s_barrier()
#define PG8_SCHED __builtin_amdgcn_sched_barrier(0)
    Unit cur, nxt; int ui = 0;
    if (!S.next(0, cur)) return;
    f32x4 acc[2][2][4][2];
#pragma unroll
    for (int a = 0; a < 2; ++a)
#pragma unroll
        for (int b = 0; b < 2; ++b)
#pragma unroll
            for (int m = 0; m < 4; ++m)
#pragma unroll
                for (int n = 0; n < 2; ++n) acc[a][b][m][n] = (f32x4){0.f, 0.f, 0.f, 0.f};
    bf16x8 At[4][2], B0[2][2], B1[2][2];
    const char* cA = (const char*)g.A + (size_t)cur.pm * tstep; const char* cB = (const char*)g.Bt + (size_t)cur.pn * tstep;
    S.a_ready(cur);
    if constexpr (SP2) {
        PG8_STAGE(PG8_SB(0, 0), cB, voffB); PG8_STAGE(PG8_SB(0, 1), cB + hstep, voffB); PG8_STAGE(PG8_SA(0, 0), cA, voffA); PG8_STAGE(PG8_SA(0, 1), cA + hstep, voffA);
        if (wr == 1) PG8_BAR;
        PG8_WAIT_V(2); PG8_BAR;
        PG8_STAGE(PG8_SB(1, 0), cB + kstep, voffB); PG8_STAGE(PG8_SA(1, 0), cA + kstep, voffA); PG8_STAGE(PG8_SB(1, 1), cB + hstep + kstep, voffB);
        PG8_WAIT_V(6); PG8_BAR;
    } else {
        PG8_STAGE(PG8_SB(0, 0), cB, voffB); PG8_STAGE(PG8_SA(0, 0), cA, voffA); PG8_STAGE(PG8_SB(0, 1), cB + hstep, voffB); PG8_STAGE(PG8_SA(0, 1), cA + hstep, voffA);
        if (wr == 1) PG8_BAR;
        PG8_WAIT_V(4); PG8_BAR;
        PG8_STAGE(PG8_SB(1, 0), cB + kstep, voffB); PG8_STAGE(PG8_SA(1, 0), cA + kstep, voffA); PG8_STAGE(PG8_SB(1, 1), cB + hstep + kstep, voffB);
        PG8_WAIT_V(6); PG8_BAR;
    }
    for (;;) {
        const bool has_next = S.next(ui + 1, nxt);
        const char* nA = has_next ? (const char*)g.A + (size_t)nxt.pm * tstep : cA; const char* nB = has_next ? (const char*)g.Bt + (size_t)nxt.pn * tstep : cB;
        for (int t = 0; t < nt; t += 2) {
            const bool last = (t == nt - 2);
            const char* a1 = cA + (size_t)(t + 1) * kstep;
            const char* a2 = last ? nA : cA + (size_t)(t + 2) * kstep; const char* b2 = last ? nB : cB + (size_t)(t + 2) * kstep;
            const char* a3 = a2 + kstep; const char* b3 = b2 + kstep;
            if (last && has_next) S.a_ready(nxt);
            if constexpr (SP2) {
            PG8_LDB(B0, 0, 0); PG8_LDB(B1, 0, 1); PG8_SCHED; PG8_LDA(At, 0, 0); PG8_STAGE(PG8_SA(1, 1), a1 + hstep, voffA);
            PG8_WAIT_V(8); PG8_WAIT_L(0); PG8_BAR; PG8_MMA(0, 0, At, B0); PG8_MMA(0, 1, At, B1); PG8_BAR; PG8_SCHED;
            PG8_LDA(At, 0, 1); PG8_STAGE(PG8_SB(0, 0), b2, voffB); PG8_STAGE(PG8_SB(0, 1), b2 + hstep, voffB); PG8_STAGE(PG8_SA(0, 0), a2, voffA);
            PG8_WAIT_V(8); PG8_WAIT_L(0); PG8_BAR; PG8_MMA(1, 0, At, B0); PG8_MMA(1, 1, At, B1); PG8_BAR; PG8_SCHED;
            PG8_LDB(B0, 1, 0); PG8_LDB(B1, 1, 1); PG8_SCHED; PG8_LDA(At, 1, 0); PG8_STAGE(PG8_SA(0, 1), a2 + hstep, voffA);
            PG8_WAIT_V(8); PG8_WAIT_L(0); PG8_BAR; PG8_MMA(0, 0, At, B0); PG8_MMA(0, 1, At, B1); PG8_BAR; PG8_SCHED;
            PG8_LDA(At, 1, 1); PG8_STAGE(PG8_SB(1, 0), b3, voffB); PG8_STAGE(PG8_SB(1, 1), b3 + hstep, voffB); PG8_STAGE(PG8_SA(1, 0), a3, voffA);
            PG8_WAIT_V(8); PG8_WAIT_L(0); PG8_BAR; PG8_MMA(1, 0, At, B0); PG8_MMA(1, 1, At, B1); PG8_BAR; PG8_SCHED;
            } else {
            PG8_LDB(B0, 0, 0); PG8_SCHED; PG8_LDA(At, 0, 0); PG8_STAGE(PG8_SA(1, 1), a1 + hstep, voffA);
            PG8_WAIT_L(8); PG8_BAR; PG8_WAIT_L(0); PG8_MMA(0, 0, At, B0); PG8_BAR; PG8_SCHED;
            PG8_LDB(B1, 0, 1); PG8_STAGE(PG8_SB(0, 0), b2, voffB);
            PG8_BAR; PG8_WAIT_L(0); PG8_MMA(0, 1, At, B1); PG8_BAR;
            PG8_LDA(At, 0, 1); PG8_STAGE(PG8_SA(0, 0), a2, voffA);
            PG8_BAR; PG8_WAIT_L(0); PG8_MMA(1, 0, At, B0); PG8_BAR; PG8_SCHED;
            PG8_STAGE(PG8_SB(0, 1), b2 + hstep, voffB);
            PG8_WAIT_V(6); PG8_BAR; PG8_MMA(1, 1, At, B1); PG8_BAR;
            PG8_LDB(B0, 1, 0); PG8_SCHED; PG8_LDA(At, 1, 0); PG8_STAGE(PG8_SA(0, 1), a2 + hstep, voffA);
            PG8_WAIT_L(8); PG8_BAR; PG8_WAIT_L(0); PG8_MMA(0, 0, At, B0); PG8_BAR; PG8_SCHED;
            PG8_LDB(B1, 1, 1); PG8_STAGE(PG8_SB(1, 0), b3, voffB);
            PG8_BAR; PG8_WAIT_L(0); PG8_MMA(0, 1, At, B1); PG8_BAR;
            PG8_LDA(At, 1, 1); PG8_STAGE(PG8_SA(1, 0), a3, voffA);
            PG8_BAR; PG8_WAIT_L(0); PG8_MMA(1, 0, At, B0); PG8_BAR; PG8_SCHED;
            PG8_STAGE(PG8_SB(1, 1), b3 + hstep, voffB);
            PG8_WAIT_V(6); PG8_BAR; PG8_MMA(1, 1, At, B1); PG8_BAR;
            }
        }
        if constexpr (ALIGN_EPI) { if (wr == 0) PG8_BAR; }
        if constexpr (!Epi::AFTER_DRAIN) { E(acc, cur, wr, wc, fr, fq); S.done(cur); }
        if (!has_next) break;
#pragma unroll
        for (int a = 0; a < 2; ++a)
#pragma unroll
            for (int b = 0; b < 2; ++b)
#pragma unroll
                for (int m = 0; m < 4; ++m)
#pragma unroll
                    for (int n = 0; n < 2; ++n) acc[a][b][m][n] = (f32x4){0.f, 0.f, 0.f, 0.f};
        cur = nxt; cA = nA; cB = nB; ++ui;
        if constexpr (ALIGN_EPI) { if (wr == 1) PG8_BAR; }
    }
    PG8_WAIT_V(0);
    if constexpr (!ALIGN_EPI) { if (wr == 0) PG8_BAR; }
    PG8_BAR;
    if constexpr (Epi::AFTER_DRAIN) { E.fused(acc, cur, wr, wc, fr, fq, lds, wid, lane); S.done(cur); }
#undef PG8_SA
#undef PG8_SB
#undef PG8_STAGE
#undef PG8_LDA
#undef PG8_LDB
#undef PG8_MMA
#undef PG8_WAIT_V
#undef PG8_WAIT_L
#undef PG8_BAR
#undef PG8_SCHED
}
}
#define LAS __attribute__((address_space(3)))
typedef unsigned short bf16_t;
typedef short bf16x8 __attribute__((ext_vector_type(8)));
typedef short s16x4 __attribute__((ext_vector_type(4)));
typedef float f32x4 __attribute__((ext_vector_type(4)));
typedef float f32x16 __attribute__((ext_vector_type(16)));
typedef unsigned u32x4 __attribute__((ext_vector_type(4)));
typedef unsigned u32x2 __attribute__((ext_vector_type(2)));
typedef float f32x2_t __attribute__((ext_vector_type(2)));
typedef __bf16 bf16x2_t __attribute__((ext_vector_type(2)));

constexpr int NBATCH = 4, T = 8192, D = 1024, DEPTH = 4, M = NBATCH * T;
constexpr int DIN = 3206, NIN = 3328, DFF = 2816, NFF = 5632;
constexpr int ZP = 2816, ZFP = 512;
constexpr int Z_QA = 0, Z_KA = 384, Z_VA = 768, Z_CV = 1152, Z_QH = 1664, Z_IH = 2048, Z_GH = 2432;
constexpr int ZF_FH = 0, ZF_FA = 384;
constexpr int MIX_ATT = 0, MIX_CNV = 384, MIX_HG = 640;
constexpr float LOG2E = 1.4426950408889634f;
constexpr float QSCALE = 0.125f * LOG2E;
constexpr int NHITEM = NBATCH * 6 * 128;
constexpr size_t MiB = 1u << 20;
constexpr size_t WS_WIN = 1 * MiB, WS_WOUT = 27 * MiB, WS_WFI = 35 * MiB, WS_WFO = 79 * MiB, WS_Z = 101 * MiB, WS_ZF = 277 * MiB, WS_XB = 341 * MiB,
                 WS_MIX = 405 * MiB, WS_KT = 469 * MiB, WS_SSQ = 493 * MiB, WS_CS = 495 * MiB, WS_KPM = 496 * MiB, WS_EM = 497 * MiB, WS_EE = 498 * MiB, WS_END = 499 * MiB;
constexpr int LDS_BYTES = 135168;

struct Args {
    const float *x, *norm_mix_g, *w_in, *fgate_b, *conv_w, *conv_b, *conv_ln_g, *conv_ln_b, *lb_logits, *hgrn_norm_g, *w_out, *norm_ffn_g, *w_ffn_in, *w_ffn_out, *norm_final_g;
    float* out; unsigned char* ws;
};

__device__ __forceinline__ unsigned cvtpk(float lo, float hi) { f32x2_t v = {lo, hi}; bf16x2_t b = __builtin_convertvector(v, bf16x2_t); return __builtin_bit_cast(unsigned, b); }
__device__ __forceinline__ float bf2f(unsigned short u) { return __uint_as_float((unsigned)u << 16); }
__device__ __forceinline__ float bflo(unsigned u) { return __uint_as_float(u << 16); }
__device__ __forceinline__ float bfhi(unsigned u) { return __uint_as_float(u & 0xffff0000u); }
__device__ __forceinline__ unsigned short f2bf(float f) { return (unsigned short)(cvtpk(f, 0.f) & 0xffffu); }
__device__ __forceinline__ float fast_rcp(float x) { return __builtin_amdgcn_rcpf(x); }
__device__ __forceinline__ float sigmoidf_(float x) { return fast_rcp(1.f + __expf(-x)); }
__device__ __forceinline__ float siluf_(float x) { return x * fast_rcp(1.f + __expf(-x)); }
__device__ __forceinline__ int crow(int r, int hi) { return (r & 3) + 8 * (r >> 2) + 4 * hi; }
__device__ __forceinline__ s16x4 trread(const LAS unsigned char* p) { typedef short v4i16_t __attribute__((ext_vector_type(4))); return __builtin_bit_cast(s16x4, __builtin_amdgcn_ds_read_tr16_b64_v4i16((LAS v4i16_t*)p)); }
__device__ __forceinline__ bf16x8 cat8(s16x4 lo, s16x4 hi) { return (bf16x8){lo[0], lo[1], lo[2], lo[3], hi[0], hi[1], hi[2], hi[3]}; }
__device__ __forceinline__ float wave_sum(float v) {
#pragma unroll
    for (int o = 1; o < 64; o <<= 1) v += __shfl_xor(v, o);
    return v;
}

__device__ __forceinline__ float row_rstd(const float* ssq, int row, int fq) {
    const f32x4 p = *(const f32x4*)(ssq + (size_t)row * 16 + 4 * fq);
    float s = (p[0] + p[1]) + (p[2] + p[3]); s += __shfl_xor(s, 16); s += __shfl_xor(s, 32);
    return rsqrtf(s * (1.0f / D) + 1e-6f);
}
struct EpiIn {
    static constexpr bool PERM = true, AFTER_DRAIN = false;
    bf16_t* Z; float* ZF; const float* ssq;
    __device__ __forceinline__ void operator()(const pg8::f32x4 (&acc)[2][2][4][2], const pg8::Unit& u, int wr, int wc, int fr, int fq) const {
        const int row0 = u.pm * 256 + wr * 64 + fr, col0 = u.pn * 256 + wc * 32 + 8 * fq;
#pragma unroll
        for (int ai = 0; ai < 2; ++ai)
#pragma unroll
            for (int m = 0; m < 4; ++m) {
                const int row = row0 + ai * 128 + m * 16; const float rs = row_rstd(ssq, row, fq);
#pragma unroll
                for (int bj = 0; bj < 2; ++bj) {
                    const f32x4 v0 = acc[ai][bj][m][0] * rs, v1 = acc[ai][bj][m][1] * rs; const int c = col0 + bj * 128;
                    if (u.pn < 11) { u32x4 w; w.x = cvtpk(v0[0], v0[1]); w.y = cvtpk(v0[2], v0[3]); w.z = cvtpk(v1[0], v1[1]); w.w = cvtpk(v1[2], v1[3]); *(u32x4*)(Z + (size_t)row * ZP + c) = w; }
                    else { float* p = ZF + (size_t)row * ZFP + (c - 2816); *(f32x4*)p = v0; *(f32x4*)(p + 4) = v1; }
                }
            }
    }
};
struct EpiRes {
    static constexpr bool PERM = true, AFTER_DRAIN = false;
    const float* base; float* out; bf16_t* xb; float* ssq;
    __device__ __forceinline__ void operator()(const pg8::f32x4 (&acc)[2][2][4][2], const pg8::Unit& u, int wr, int wc, int fr, int fq) const {
        const int row0 = u.pm * 256 + wr * 64 + fr, col0 = u.pn * 256 + wc * 32 + 8 * fq;
#pragma unroll
        for (int ai = 0; ai < 2; ++ai)
#pragma unroll
            for (int m = 0; m < 4; ++m) {
                const int row = row0 + ai * 128 + m * 16; float q = 0.f;
#pragma unroll
                for (int bj = 0; bj < 2; ++bj) {
                    const size_t off = (size_t)row * D + col0 + bj * 128;
                    const f32x4 v0 = acc[ai][bj][m][0] + *(const f32x4*)(base + off), v1 = acc[ai][bj][m][1] + *(const f32x4*)(base + off + 4);
                    *(f32x4*)(out + off) = v0; *(f32x4*)(out + off + 4) = v1;
                    u32x4 w; w.x = cvtpk(v0[0], v0[1]); w.y = cvtpk(v0[2], v0[3]); w.z = cvtpk(v1[0], v1[1]); w.w = cvtpk(v1[2], v1[3]); *(u32x4*)(xb + off) = w;
                    q += (v0[0] * v0[0] + v0[1] * v0[1]) + (v0[2] * v0[2] + v0[3] * v0[3]) + (v1[0] * v1[0] + v1[1] * v1[1]) + (v1[2] * v1[2] + v1[3] * v1[3]);
                }
                q += __shfl_xor(q, 16); q += __shfl_xor(q, 32);
                if (fq == 0) ssq[(size_t)row * 16 + u.pn * 4 + wc] = q;
            }
    }
};
struct EpiGlu {
    static constexpr bool PERM = true, AFTER_DRAIN = false;
    bf16_t* H; const float* ssq;
    __device__ __forceinline__ void operator()(const pg8::f32x4 (&acc)[2][2][4][2], const pg8::Unit& u, int wr, int wc, int fr, int fq) const {
        const int row0 = u.pm * 256 + wr * 64 + fr, col0 = u.pn * 128 + wc * 32 + 8 * fq;
#pragma unroll
        for (int ai = 0; ai < 2; ++ai)
#pragma unroll
            for (int m = 0; m < 4; ++m) {
                const int row = row0 + ai * 128 + m * 16; const float rs = row_rstd(ssq, row, fq);
                float hv[8];
#pragma unroll
                for (int n = 0; n < 2; ++n)
#pragma unroll
                    for (int e = 0; e < 4; ++e) { const float g = acc[ai][0][m][n][e] * rs, up = acc[ai][1][m][n][e] * rs; hv[n * 4 + e] = siluf_(g) * up; }
                u32x4 w; w.x = cvtpk(hv[0], hv[1]); w.y = cvtpk(hv[2], hv[3]); w.z = cvtpk(hv[4], hv[5]); w.w = cvtpk(hv[6], hv[7]);
                *(u32x4*)(H + (size_t)row * DFF + col0) = w;
            }
    }
};
__device__ __forceinline__ int map_win(int n) {
    if (n < 1152) return n;
    if (n < 1158) return 3200 + (n - 1152);
    if (n < 1670) return Z_CV + (n - 1158);
    if (n < 2054) return Z_QH + (n - 1670);
    if (n < 2438) return 2816 + (n - 2054);
    if (n < 2822) return Z_IH + (n - 2438);
    return Z_GH + (n - 2822);
}
template <int MODE>
__device__ __forceinline__ void transpose_item(const float* W, int K, int N, bf16_t* WT, const float* gs, LAS float* scr, int item, int lane) {
    const int nblk = (N + 31) / 32, kb = item / nblk, nb = item % nblk, k0 = 64 * kb, n0 = 32 * nb;
    const int nn = n0 + (lane & 31);
#pragma unroll 8
    for (int i = 0; i < 32; ++i) { const int kk = 2 * i + (lane >> 5); float v = (nn < N) ? W[(size_t)(k0 + kk) * N + nn] : 0.f; if (gs) v *= gs[k0 + kk]; scr[kk * 33 + (lane & 31)] = v; }
    asm volatile("s_waitcnt lgkmcnt(0)" ::: "memory");
    const int c = lane & 7;
#pragma unroll
    for (int j = 0; j < 4; ++j) {
        const int nl = (lane >> 3) + 8 * j, n = n0 + nl; const LAS float* s = scr + (8 * c) * 33 + nl;
        if (n < N) {
            int row; float sc = 1.f;
            if (MODE == 0) { row = map_win(n); if (n < 384) sc = QSCALE; }
            else if (MODE == 2) { row = (n < DFF) ? ((n >> 7) * 256 + (n & 127)) : ((((n - DFF) >> 7) * 256) + 128 + ((n - DFF) & 127)); }
            else row = n;
            u32x4 o; o.x = cvtpk(s[0 * 33] * sc, s[1 * 33] * sc); o.y = cvtpk(s[2 * 33] * sc, s[3 * 33] * sc); o.z = cvtpk(s[4 * 33] * sc, s[5 * 33] * sc); o.w = cvtpk(s[6 * 33] * sc, s[7 * 33] * sc);
            *(u32x4*)(WT + (size_t)row * K + k0 + 8 * c) = o;
        }
    }
    asm volatile("s_waitcnt lgkmcnt(0)" ::: "memory");
}
__device__ __forceinline__ void prologue(const Args& a, LAS unsigned char* lds, int G, int bx) {
    const int tid = opaque_tid(), lane = tid & 63, wid = __builtin_amdgcn_readfirstlane(tid >> 6), gw = bx * 8 + wid, NGW = G * 8;
    LAS float* scr = (LAS float*)(lds + wid * 16384);
    constexpr int I_IN = 16 * 101, I_OUT = 16 * 32, I_FI = 16 * 176, I_FO = 44 * 32, I_L = I_IN + I_OUT + I_FI + I_FO;
    for (int it = gw; it < DEPTH * I_L; it += NGW) {
        const int l = it / I_L; int r = it % I_L;
        if (r < I_IN) { transpose_item<0>(a.w_in + (size_t)l * D * DIN, D, DIN, (bf16_t*)(a.ws + WS_WIN) + (size_t)l * NIN * D, a.norm_mix_g + l * D, scr, r, lane); continue; } r -= I_IN;
        if (r < I_OUT) { transpose_item<1>(a.w_out + (size_t)l * D * D, D, D, (bf16_t*)(a.ws + WS_WOUT) + (size_t)l * D * D, nullptr, scr, r, lane); continue; } r -= I_OUT;
        if (r < I_FI) { transpose_item<2>(a.w_ffn_in + (size_t)l * D * NFF, D, NFF, (bf16_t*)(a.ws + WS_WFI) + (size_t)l * NFF * D, a.norm_ffn_g + l * D, scr, r, lane); continue; } r -= I_FI;
        transpose_item<1>(a.w_ffn_out + (size_t)l * DFF * D, DFF, D, (bf16_t*)(a.ws + WS_WFO) + (size_t)l * D * DFF, nullptr, scr, r, lane);
    }
    bf16_t* xb = (bf16_t*)(a.ws + WS_XB); float* ssq = (float*)(a.ws + WS_SSQ);
    for (int m = gw; m < M; m += NGW) {
        const f32x4* xr = (const f32x4*)(a.x + (size_t)m * D) + lane; float s = 0.f;
        u32x2* o8 = (u32x2*)(xb + (size_t)m * D) + lane;
#pragma unroll
        for (int j = 0; j < 4; ++j) { const f32x4 v = xr[64 * j]; s += (v[0] * v[0] + v[1] * v[1]) + (v[2] * v[2] + v[3] * v[3]); u32x2 w; w.x = cvtpk(v[0], v[1]); w.y = cvtpk(v[2], v[3]); o8[64 * j] = w; }
        s = wave_sum(s);
        if (lane < 16) ssq[(size_t)m * 16 + lane] = (lane == 0) ? s : 0.f;
    }
}
__device__ __forceinline__ void final_norm(const Args& a, int G, int bx) {
    const int tid = opaque_tid(), lane = tid & 63, wid = __builtin_amdgcn_readfirstlane(tid >> 6), gw = bx * 8 + wid, NGW = G * 8;
    for (int m = gw; m < M; m += NGW) {
        f32x4* xr = (f32x4*)(a.out + (size_t)m * D) + lane; const f32x4* gr = (const f32x4*)a.norm_final_g + lane;
        f32x4 v[4]; float s = 0.f;
#pragma unroll
        for (int j = 0; j < 4; ++j) { v[j] = xr[64 * j]; s += (v[j][0] * v[j][0] + v[j][1] * v[j][1]) + (v[j][2] * v[j][2] + v[j][3] * v[j][3]); }
        const float rs = rsqrtf(wave_sum(s) * (1.f / D) + 1e-6f);
#pragma unroll
        for (int j = 0; j < 4; ++j) xr[64 * j] = v[j] * rs * gr[64 * j];
    }
}

__device__ __forceinline__ void attn_prep(LAS unsigned char* L, const bf16_t* Z, const float* ZF, const float* fgb, float* cs, float* kpm, int bh) {
    const int tid = opaque_tid(), lane = tid & 63, wid = tid >> 6, b = bh / 6, h = bh % 6;
    LAS float* wtot = (LAS float*)L;
    LAS float* tm = (LAS float*)(L + 64);
    LAS float* tl = (LAS float*)(L + 64 + 2048);
    const float fb = fgb[h];
    float lf[16]; float s = 0.f;
    const size_t r0 = (size_t)b * T + 16 * tid;
#pragma unroll
    for (int i = 0; i < 16; ++i) { const float x = ZF[(r0 + i) * ZFP + ZF_FA + h] + fb; lf[i] = fminf(x, 0.f) - log1pf(__expf(-fabsf(x))); s += lf[i]; }
    float inc = s;
#pragma unroll
    for (int o = 1; o < 64; o <<= 1) { const float t = __shfl_up(inc, o); if (lane >= o) inc += t; }
    if (lane == 63) wtot[wid] = inc;
    float mx = 0.f;
#pragma unroll 4
    for (int i = 0; i < 16; ++i) {
        const u32x4* kp = (const u32x4*)(Z + (r0 + i) * ZP + Z_KA + h * 64); float n2 = 0.f;
#pragma unroll
        for (int c = 0; c < 8; ++c) { const u32x4 w = kp[c];
#pragma unroll
            for (int e = 0; e < 4; ++e) { const float lo = bflo(w[e]), hi = bfhi(w[e]); n2 += lo * lo + hi * hi; } }
        mx = fmaxf(mx, n2);
    }
    tm[tid] = mx;
    __syncthreads();
    float run = inc - s;
    for (int w = 0; w < wid; ++w) run += wtot[w];
#pragma unroll
    for (int i = 0; i < 16; ++i) { run += lf[i]; cs[(size_t)bh * T + 16 * tid + i] = run; }
    if (tid < 128) tl[tid] = fmaxf(fmaxf(tm[4 * tid], tm[4 * tid + 1]), fmaxf(tm[4 * tid + 2], tm[4 * tid + 3]));
    __syncthreads();
    if (tid < 128) { float p = 0.f; for (int i = 0; i <= tid; ++i) p = fmaxf(p, tl[i]); kpm[bh * 128 + tid] = p; }
    __syncthreads();
}

constexpr int AK_STR = 144, AV_STR = 192, AK_BYTES = 64 * AK_STR, AV_BYTES = 64 * AV_STR, A_VOFF = 2 * AK_BYTES, A_BOFF = A_VOFF + 2 * AV_BYTES, A_VOTE = A_BOFF + 512;
__device__ __forceinline__ void attn_unit(LAS unsigned char* L, const bf16_t* Z, const float* cs, const float* kpm, bf16_t* MIX, int bh, int qb) {
    const int tid = opaque_tid(), lane = tid & 63, r32 = lane & 31, hi = lane >> 5; const int wid = __builtin_amdgcn_readfirstlane(tid >> 6);
    const int b = bh / 6, h = bh % 6; const size_t rowbase = (size_t)b * T; const int q0 = qb * 256, t0 = q0 + wid * 32;
    bf16x8 qr[4];
    { const bf16_t* Qp = Z + (rowbase + t0 + r32) * ZP + Z_QA + h * 64 + hi * 8;
#pragma unroll
      for (int d0 = 0; d0 < 4; ++d0) qr[d0] = *(const bf16x8*)(Qp + d0 * 16); }
    float qn2 = 0.f;
#pragma unroll
    for (int d0 = 0; d0 < 4; ++d0)
#pragma unroll
        for (int e = 0; e < 8; ++e) { const float v = bf2f((unsigned short)qr[d0][e]); qn2 += v * v; }
    qn2 += __shfl_xor(qn2, 32);
    const float qn = sqrtf(qn2) * 1.001f;
    const float* csb = cs + (size_t)bh * T; const float cref = csb[q0];
    const int srow = tid >> 3, sch = tid & 7;
    const bf16_t* Kg = Z + rowbase * ZP + Z_KA + h * 64 + sch * 8; const bf16_t* Vg = Z + rowbase * ZP + Z_VA + h * 64 + sch * 8;
    int j = (q0 + 256) / 64 - 1;
    u32x4 kreg = *(const u32x4*)(Kg + (size_t)(64 * j + srow) * ZP), vreg = *(const u32x4*)(Vg + (size_t)(64 * j + srow) * ZP);
    float cval = (tid < 64) ? csb[64 * j + tid] : 0.f;
    *(LAS u32x4*)(L + srow * AK_STR + sch * 16) = kreg; *(LAS u32x4*)(L + A_VOFF + srow * AV_STR + sch * 16) = vreg;
    if (tid < 64) ((LAS float*)(L + A_BOFF))[tid] = (cref - cval) * LOG2E;
    __syncthreads();
    float m = -1e30f, l = 0.f; f32x16 o[2]; o[0] = f32x16{}; o[1] = f32x16{};
    int buf = 0;
    const int tq = (lane & 15) >> 2, tp = lane & 3, tg1 = (lane >> 4) & 1;
    for (;;) {
        const bool more = j > 0;
        if (more) { kreg = *(const u32x4*)(Kg + (size_t)(64 * (j - 1) + srow) * ZP); vreg = *(const u32x4*)(Vg + (size_t)(64 * (j - 1) + srow) * ZP); cval = (tid < 64) ? csb[64 * (j - 1) + tid] : 0.f; }
        const int k0 = 64 * j;
        if (k0 <= t0 + 31) {
            const LAS unsigned char* Kb = L + buf * AK_BYTES; const LAS unsigned char* Vb = L + A_VOFF + buf * AV_BYTES;
            const LAS float* kbp = (const LAS float*)(L + A_BOFF + buf * 256) + 4 * hi;
            f32x16 p0, p1;
#pragma unroll
            for (int i = 0; i < 4; ++i) { const f32x4 ta = *(const LAS f32x4*)(kbp + 8 * i), tb = *(const LAS f32x4*)(kbp + 32 + 8 * i);
#pragma unroll
                for (int e = 0; e < 4; ++e) { p0[4 * i + e] = ta[e]; p1[4 * i + e] = tb[e]; } }
#pragma unroll
            for (int d0 = 0; d0 < 4; ++d0) {
                const bf16x8 a0 = *(const LAS bf16x8*)(Kb + r32 * AK_STR + d0 * 32 + hi * 16), a1 = *(const LAS bf16x8*)(Kb + (32 + r32) * AK_STR + d0 * 32 + hi * 16);
                p0 = __builtin_amdgcn_mfma_f32_32x32x16_bf16(a0, qr[d0], p0, 0, 0, 0); p1 = __builtin_amdgcn_mfma_f32_32x32x16_bf16(a1, qr[d0], p1, 0, 0, 0);
            }
            if (k0 + 63 > t0) { const int tt = t0 + r32;
#pragma unroll
                for (int r = 0; r < 16; ++r) { const int kv = k0 + crow(r, hi); if (kv > tt) p0[r] = -INFINITY; if (kv + 32 > tt) p1[r] = -INFINITY; } }
            float mx = fmaxf(p0[0], p1[0]);
#pragma unroll
            for (int r = 1; r < 16; ++r) mx = fmaxf(mx, fmaxf(p0[r], p1[r]));
            mx = fmaxf(mx, __shfl_xor(mx, 32));
            const float mnew = fmaxf(m, mx), alpha = __builtin_amdgcn_exp2f(m - mnew);
            float sum = 0.f;
#pragma unroll
            for (int r = 0; r < 16; ++r) { p0[r] = __builtin_amdgcn_exp2f(p0[r] - mnew); p1[r] = __builtin_amdgcn_exp2f(p1[r] - mnew); sum += p0[r] + p1[r]; }
            l = l * alpha + sum; m = mnew;
#pragma unroll
            for (int r = 0; r < 16; ++r) { o[0][r] *= alpha; o[1][r] *= alpha; }
            u32x4 pw[4];
#pragma unroll
            for (int e = 0; e < 4; ++e) { pw[0][e] = cvtpk(p0[2 * e], p0[2 * e + 1]); pw[1][e] = cvtpk(p0[8 + 2 * e], p0[9 + 2 * e]); pw[2][e] = cvtpk(p1[2 * e], p1[2 * e + 1]); pw[3][e] = cvtpk(p1[8 + 2 * e], p1[9 + 2 * e]); }
#pragma unroll
            for (int dh = 0; dh < 2; ++dh)
#pragma unroll
                for (int s = 0; s < 4; ++s) {
                    const LAS unsigned char* ap = Vb + (16 * s + 4 * hi + tq) * AV_STR + (32 * dh + 16 * tg1 + 4 * tp) * 2;
                    const bf16x8 vf = cat8(trread(ap), trread(ap + 8 * AV_STR));
                    o[dh] = __builtin_amdgcn_mfma_f32_32x32x16_bf16(vf, __builtin_bit_cast(bf16x8, pw[s]), o[dh], 0, 0, 0);
                }
        }
        if (more) {
            const int nb = buf ^ 1;
            *(LAS u32x4*)(L + nb * AK_BYTES + srow * AK_STR + sch * 16) = kreg; *(LAS u32x4*)(L + A_VOFF + nb * AV_BYTES + srow * AV_STR + sch * 16) = vreg;
            if (tid < 64) ((LAS float*)(L + A_BOFF + nb * 256))[tid] = (cref - cval) * LOG2E;
            const float kmax = sqrtf(kpm[bh * 128 + j - 1]) * 1.001f, bmax = (cref - csb[64 * (j - 1) + 63]) * LOG2E;
            const int vote = __all((qn * kmax + bmax - m) < -170.f);
            if (lane == 0) ((LAS int*)(L + A_VOTE + nb * 32))[wid] = vote;
        }
        __syncthreads();
        if (!more) break;
        { const LAS int* vp = (const LAS int*)(L + A_VOTE + (buf ^ 1) * 32); int all = 1;
#pragma unroll
          for (int w = 0; w < 8; ++w) all &= vp[w];
          if (all) break; }
        --j; buf ^= 1;
    }
    l += __shfl_xor(l, 32);
    const float inv = 1.0f / l;
    bf16_t* Op = MIX + (rowbase + t0 + r32) * D + MIX_ATT + h * 64;
#pragma unroll
    for (int dh = 0; dh < 2; ++dh)
#pragma unroll
        for (int g = 0; g < 4; ++g) { u32x2 w; w.x = cvtpk(o[dh][4 * g] * inv, o[dh][4 * g + 1] * inv); w.y = cvtpk(o[dh][4 * g + 2] * inv, o[dh][4 * g + 3] * inv); *(u32x2*)(Op + 32 * dh + 8 * g + 4 * hi) = w; }
    __syncthreads();
}

__device__ __forceinline__ void conv_item(LAS unsigned char* L, const bf16_t* Z, const float* cw, const float* cb, const float* lg, const float* lb, bf16_t* MIX, int item) {
    const int tid = opaque_tid(), lane = tid & 63, wid = tid >> 6; const int b = item >> 8, t0 = (item & 255) * 32; const size_t rowbase = (size_t)b * T;
    LAS float* hs = (LAS float*)L;
    LAS float* ob = (LAS float*)(L + 62 * 1024);
    for (int ci = tid; ci < 62 * 32; ci += 512) {
        const int r = ci >> 5, ch = ci & 31, t = t0 - 30 + r; f32x4 h0 = {0.f, 0.f, 0.f, 0.f}, h1 = h0;
        if (t >= 0) { const bf16_t* p = Z + (rowbase + t) * ZP + Z_CV + ch * 8; const u32x4 av = *(const u32x4*)p, gv = *(const u32x4*)(p + 256);
#pragma unroll
            for (int e = 0; e < 2; ++e) { h0[2 * e] = bflo(av[e]) * sigmoidf_(bflo(gv[e])); h0[2 * e + 1] = bfhi(av[e]) * sigmoidf_(bfhi(gv[e])); h1[2 * e] = bflo(av[2 + e]) * sigmoidf_(bflo(gv[2 + e])); h1[2 * e + 1] = bfhi(av[2 + e]) * sigmoidf_(bfhi(gv[2 + e])); } }
        *(LAS f32x4*)(hs + r * 256 + ch * 8) = h0; *(LAS f32x4*)(hs + r * 256 + ch * 8 + 4) = h1;
    }
    __syncthreads();
    { const int c = tid & 255, half = tid >> 8; float w[31];
#pragma unroll
      for (int jj = 0; jj < 31; ++jj) w[jj] = cw[jj * 256 + c];
      const float bias = cb[c];
      for (int tt = 0; tt < 16; ++tt) { const int tl = 16 * half + tt; float acc = bias;
#pragma unroll
          for (int jj = 0; jj < 31; ++jj) acc += w[jj] * hs[(tl + jj) * 256 + c];
          ob[tl * 256 + c] = acc; } }
    __syncthreads();
    { const f32x4 g4 = *(const f32x4*)(lg + 4 * lane), b4 = *(const f32x4*)(lb + 4 * lane);
#pragma unroll
      for (int k = 0; k < 4; ++k) { const int tl = 4 * wid + k; const f32x4 v = *(const LAS f32x4*)(ob + tl * 256 + 4 * lane);
          const float mu = wave_sum((v[0] + v[1]) + (v[2] + v[3])) * (1.f / 256.f); const f32x4 d = v - mu;
          const float var = wave_sum((d[0] * d[0] + d[1] * d[1]) + (d[2] * d[2] + d[3] * d[3])) * (1.f / 256.f); const float rs = rsqrtf(var + 1e-5f);
          const f32x4 y = d * rs * g4 + b4; u32x2 w; w.x = cvtpk(siluf_(y[0]), siluf_(y[1])); w.y = cvtpk(siluf_(y[2]), siluf_(y[3]));
          *(u32x2*)(MIX + (rowbase + t0 + tl) * D + MIX_CNV + 4 * lane) = w; } }
    __syncthreads();
}
__device__ __forceinline__ void hgrn_load_v(LAS unsigned char* vimg, const bf16_t* Z, size_t R0, int hh, int lane) {
#pragma unroll
    for (int it = 0; it < 8; ++it) { const int idx = it * 64 + lane, row = idx >> 3, ch = idx & 7; *(LAS u32x4*)(vimg + row * 128 + ch * 16) = *(const u32x4*)(Z + (R0 + row) * ZP + Z_IH + hh * 64 + ch * 8); }
}
__device__ __forceinline__ void hgrn_elem(float z, float lb, float oml, float& kk, float& g) {
    const float ez = __expf(-fabsf(z)), r = fast_rcp(1.f + ez), sp = r, sn = ez * r;
    const float sg = z >= 0.f ? sp : sn, oms = z >= 0.f ? sn : sp;
    const float f = fmaxf(lb + oml * sg, 1e-30f); kk = oml * oms; g = __logf(f);
}
__device__ __forceinline__ void hgrn_a(LAS unsigned char* Lw, const bf16_t* Z, bf16_t* MIX, const float* ZF, bf16_t* KT, const float* lbl, int layer, float* UT, float* EM, float* EE, int item, int lane) {
    const int c = item & 127, bhh = item >> 7, hh = bhh % 6, b = bhh / 6;
    const size_t R0 = (size_t)b * T + 64 * c; const int col = hh * 64 + lane;
    float lb;
    { float lg[4], mx = -1e30f;
#pragma unroll
      for (int i = 0; i < 4; ++i) { lg[i] = lbl[i * 384 + col]; mx = fmaxf(mx, lg[i]); }
      float se = 0.f, num = 0.f;
#pragma unroll
      for (int i = 0; i < 4; ++i) { const float e = __expf(lg[i] - mx); se += e; if (i >= 1 && i <= layer) num += e; }
      lb = num / se; }
    const float oml = 1.f - lb;
    LAS unsigned char* kimg = Lw; LAS unsigned char* vimg = Lw + 8192;
    hgrn_load_v(vimg, Z, R0, hh, lane);
    float nb = 0.f;
#pragma unroll 1
    for (int bt = 0; bt < 2; ++bt) {
        const int base = 16 - 16 * bt; float zv[16]; unsigned short qv[16];
#pragma unroll
        for (int i = 0; i < 16; ++i) { zv[i] = ZF[(R0 + base + i) * ZFP + ZF_FH + col]; qv[i] = Z[(R0 + base + i) * ZP + Z_QH + col]; }
#pragma unroll
        for (int i = 15; i >= 0; --i) { const int t = base + i; float kk, g; hgrn_elem(zv[i], lb, oml, kk, g);
            const unsigned short qt = f2bf(bf2f(qv[i]) * __expf(-nb)), kt = f2bf(kk * __expf(nb));
            MIX[(R0 + t) * D + MIX_HG + col] = qt; KT[(R0 + t) * 384 + col] = kt; *(LAS unsigned short*)(kimg + t * 128 + lane * 2) = kt; nb += g; }
    }
    float fa = 0.f;
#pragma unroll 1
    for (int bt = 0; bt < 2; ++bt) {
        const int base = 32 + 16 * bt; float zv[16]; unsigned short qv[16];
#pragma unroll
        for (int i = 0; i < 16; ++i) { zv[i] = ZF[(R0 + base + i) * ZFP + ZF_FH + col]; qv[i] = Z[(R0 + base + i) * ZP + Z_QH + col]; }
#pragma unroll
        for (int i = 0; i < 16; ++i) { const int t = base + i; float kk, g; hgrn_elem(zv[i], lb, oml, kk, g); fa += g;
            const unsigned short qt = f2bf(bf2f(qv[i]) * __expf(fa)), kt = f2bf(kk * __expf(-fa));
            MIX[(R0 + t) * D + MIX_HG + col] = qt; KT[(R0 + t) * 384 + col] = kt; *(LAS unsigned short*)(kimg + t * 128 + lane * 2) = kt; }
    }
    EM[(size_t)item * 64 + lane] = __expf(nb); EE[(size_t)item * 64 + lane] = __expf(nb + fa);
    const float usc = __expf(fa);
    asm volatile("s_waitcnt lgkmcnt(0)" ::: "memory");
    const int tq = (lane & 15) >> 2, tp = lane & 3, tg1 = (lane >> 4) & 1, hi = lane >> 5, r32 = lane & 31;
#pragma unroll
    for (int vh = 0; vh < 2; ++vh)
#pragma unroll
        for (int dh = 0; dh < 2; ++dh) {
            f32x16 acc = f32x16{};
#pragma unroll
            for (int st = 0; st < 4; ++st) {
                const LAS unsigned char* ap = vimg + (16 * st + 8 * hi + tq) * 128 + (32 * vh + 16 * tg1 + 4 * tp) * 2;
                const LAS unsigned char* bp = kimg + (16 * st + 8 * hi + tq) * 128 + (32 * dh + 16 * tg1 + 4 * tp) * 2;
                acc = __builtin_amdgcn_mfma_f32_32x32x16_bf16(cat8(trread(ap), trread(ap + 4 * 128)), cat8(trread(bp), trread(bp + 4 * 128)), acc, 0, 0, 0);
            }
            const float sc = __shfl(usc, 32 * dh + r32);
#pragma unroll
            for (int r = 0; r < 16; ++r) UT[(size_t)item * 4096 + (32 * vh + crow(r, hi)) * 64 + 32 * dh + r32] = acc[r] * sc;
        }
    asm volatile("s_waitcnt lgkmcnt(0)" ::: "memory");
}
__device__ __forceinline__ void hgrn_scan(const float* UT, const float* EM, const float* EE, bf16_t* SP, int item) {
    const int bhh = item >> 3, seg = item & 7, e = seg * 512 + opaque_tid(), dk = e & 63;
    float S = 0.f;
#pragma unroll 1
    for (int c0 = 0; c0 < 128; c0 += 8) {
        float u[8], em[8], ee[8];
#pragma unroll
        for (int i = 0; i < 8; ++i) { const size_t it = (size_t)bhh * 128 + c0 + i; u[i] = UT[it * 4096 + e]; em[i] = EM[it * 64 + dk]; ee[i] = EE[it * 64 + dk]; }
#pragma unroll
        for (int i = 0; i < 8; ++i) { const size_t it = (size_t)bhh * 128 + c0 + i; SP[it * 4096 + e] = f2bf(em[i] * S); S = ee[i] * S + u[i]; }
    }
}
__device__ __forceinline__ void hgrn_o(LAS unsigned char* Lw, const bf16_t* Z, const bf16_t* KT, const bf16_t* SP, const float* ng, bf16_t* MIX, int item, int lane) {
    const int c = item & 127, bhh = item >> 7, hh = bhh % 6, b = bhh / 6;
    const size_t R0 = (size_t)b * T + 64 * c;
    const int tq = (lane & 15) >> 2, tp = lane & 3, tg1 = (lane >> 4) & 1, hi = lane >> 5, r32 = lane & 31;
    LAS unsigned char* vimg = Lw;
    hgrn_load_v(vimg, Z, R0, hh, lane);
    asm volatile("s_waitcnt lgkmcnt(0)" ::: "memory");
#pragma unroll 1
    for (int tau = 0; tau < 2; ++tau) {
        bf16x8 qf[4];
        { const bf16_t* qp = MIX + (R0 + 32 * tau + r32) * D + MIX_HG + hh * 64 + 8 * hi;
#pragma unroll
          for (int st = 0; st < 4; ++st) qf[st] = *(const bf16x8*)(qp + 16 * st); }
        f32x16 X[2];
#pragma unroll
        for (int sh = 0; sh < 2; ++sh) { X[sh] = f32x16{}; const bf16_t* kp = KT + (R0 + 32 * sh + r32) * 384 + hh * 64 + 8 * hi;
#pragma unroll
            for (int st = 0; st < 4; ++st) X[sh] = __builtin_amdgcn_mfma_f32_32x32x16_bf16(*(const bf16x8*)(kp + 16 * st), qf[st], X[sh], 0, 0, 0); }
        const int t = 32 * tau + r32;
#pragma unroll
        for (int sh = 0; sh < 2; ++sh)
#pragma unroll
            for (int r = 0; r < 16; ++r) if (32 * sh + crow(r, hi) > t) X[sh][r] = 0.f;
        u32x4 pw[4];
#pragma unroll
        for (int e = 0; e < 4; ++e) { pw[0][e] = cvtpk(X[0][2 * e], X[0][2 * e + 1]); pw[1][e] = cvtpk(X[0][8 + 2 * e], X[0][9 + 2 * e]); pw[2][e] = cvtpk(X[1][2 * e], X[1][2 * e + 1]); pw[3][e] = cvtpk(X[1][8 + 2 * e], X[1][9 + 2 * e]); }
        f32x16 Y[2];
#pragma unroll
        for (int vh = 0; vh < 2; ++vh) { Y[vh] = f32x16{};
#pragma unroll
            for (int st = 0; st < 4; ++st) { const LAS unsigned char* ap = vimg + (16 * st + 4 * hi + tq) * 128 + (32 * vh + 16 * tg1 + 4 * tp) * 2;
                Y[vh] = __builtin_amdgcn_mfma_f32_32x32x16_bf16(cat8(trread(ap), trread(ap + 8 * 128)), __builtin_bit_cast(bf16x8, pw[st]), Y[vh], 0, 0, 0); }
            const bf16_t* sp = SP + ((size_t)item * 64 + 32 * vh + r32) * 64 + 8 * hi;
#pragma unroll
            for (int ds = 0; ds < 4; ++ds) Y[vh] = __builtin_amdgcn_mfma_f32_32x32x16_bf16(*(const bf16x8*)(sp + 16 * ds), qf[ds], Y[vh], 0, 0, 0); }
        float ss = 0.f;
#pragma unroll
        for (int r = 0; r < 16; ++r) ss += Y[0][r] * Y[0][r] + Y[1][r] * Y[1][r];
        ss += __shfl_xor(ss, 32);
        const float rs = rsqrtf(ss * (1.f / 64.f) + 1e-6f);
        const size_t R = R0 + t;
#pragma unroll
        for (int vh = 0; vh < 2; ++vh)
#pragma unroll
            for (int g4 = 0; g4 < 4; ++g4) { const int v0 = 32 * vh + 8 * g4 + 4 * hi;
                const u32x2 gw = *(const u32x2*)(Z + R * ZP + Z_GH + hh * 64 + v0); const f32x4 n4 = *(const f32x4*)(ng + v0);
                const float y0 = Y[vh][4 * g4] * rs * n4[0] * siluf_(bflo(gw.x)), y1 = Y[vh][4 * g4 + 1] * rs * n4[1] * siluf_(bfhi(gw.x));
                const float y2 = Y[vh][4 * g4 + 2] * rs * n4[2] * siluf_(bflo(gw.y)), y3 = Y[vh][4 * g4 + 3] * rs * n4[3] * siluf_(bfhi(gw.y));
                u32x2 w; w.x = cvtpk(y0, y1); w.y = cvtpk(y2, y3); *(u32x2*)(MIX + R * D + MIX_HG + hh * 64 + v0) = w; }
    }
    asm volatile("s_waitcnt lgkmcnt(0)" ::: "memory");
}

#define XB_TMO      128
#define XB_XCNT(j)  (256  + 64 * (j))
#define XB_XSUB(j)  (1280 + 64 * (j))
#define XB_XGEN(j)  (2304 + 64 * (j))
#define XB_TOP      3328
#define XB_TOPGEN   3392
#define XCD_BAR_WORDS 3456
#define XB_SPIN_CAP (1u << 18)

__device__ __forceinline__ unsigned xb_ld(unsigned* p)              { return __hip_atomic_load(p, __ATOMIC_RELAXED, __HIP_MEMORY_SCOPE_AGENT); }
__device__ __forceinline__ unsigned xb_add(unsigned* p, unsigned v) { return __hip_atomic_fetch_add(p, v, __ATOMIC_RELAXED, __HIP_MEMORY_SCOPE_AGENT); }
__device__ __forceinline__ unsigned xb_xcc_id() { return (unsigned)__builtin_amdgcn_s_getreg((3 << 11) | 20) & 0xFu; }
#define XB_SPIN(cond, bar) do { unsigned _sp = 0; while (cond) { __builtin_amdgcn_s_sleep(1); \
    if ((++_sp & 255u) == 0u) { if (xb_ld(&(bar)[XB_TMO])) break; if (_sp > XB_SPIN_CAP) { atomicAdd(&(bar)[XB_TMO], 1u); break; } } } } while (0)

struct XcdBarrier {
    unsigned* bar; unsigned x;
    volatile LAS unsigned* st;
};

__device__ __forceinline__ XcdBarrier xcd_barrier_post(unsigned* bar, volatile LAS unsigned* st) {
    XcdBarrier b; b.bar = bar; b.x = xb_xcc_id(); b.st = st;
    if (threadIdx.x == 0) (void)xb_add(&bar[XB_XCNT(b.x)], 1u);
    return b;
}
__device__ __forceinline__ void xcd_barrier_complete(unsigned* bar, unsigned x, unsigned& nloc, unsigned& nx) {
    const unsigned G = gridDim.x * gridDim.y * gridDim.z;
    unsigned sum, cnt, mine, sp = 0u;
    for (;;) {
        sum = 0u; cnt = 0u; mine = 0u;
#pragma unroll
        for (unsigned j = 0; j < 16; ++j) { const unsigned c = xb_ld(&bar[XB_XCNT(j)]); sum += c; cnt += (c > 0u) ? 1u : 0u; mine = (j == x) ? c : mine; }
        if (sum == G) break;
        __builtin_amdgcn_s_sleep(1);
        if ((++sp & 255u) == 0u) { if (xb_ld(&bar[XB_TMO])) break; if (sp > XB_SPIN_CAP) { atomicAdd(&bar[XB_TMO], 1u); break; } }
    }
    nloc = mine > 0u ? mine : 1u; nx = cnt > 0u ? cnt : 1u;
}

__device__ __forceinline__ void xcd_barrier(const XcdBarrier& b) {
    asm volatile("s_waitcnt vmcnt(0)" ::: "memory");
    __syncthreads();
    if (threadIdx.x == 0) {
        unsigned* bar = b.bar;
        __builtin_amdgcn_s_waitcnt(0);
        unsigned nloc = b.st[0], nx = b.st[1];
        if (nloc == 0u) { xcd_barrier_complete(bar, b.x, nloc, nx); b.st[0] = nloc; b.st[1] = nx; }
        const unsigned old = xb_add(&bar[XB_XSUB(b.x)], 1u);
        const unsigned gen = old / nloc;
        if (old + 1u == (gen + 1u) * nloc) {
            __builtin_amdgcn_fence(__ATOMIC_RELEASE, "agent");
            asm volatile("s_waitcnt vmcnt(0)" ::: "memory");
            const unsigned og = xb_add(&bar[XB_TOP], 1u);
            const unsigned tg = og / nx;
            if (og + 1u == (tg + 1u) * nx) xb_add(&bar[XB_TOPGEN], 1u);
            else XB_SPIN(xb_ld(&bar[XB_TOPGEN]) == tg, bar);
            __builtin_amdgcn_fence(__ATOMIC_ACQUIRE, "agent");
            xb_add(&bar[XB_XGEN(b.x)], 1u);
            asm volatile("s_waitcnt vmcnt(0)" ::: "memory");
        } else {
            XB_SPIN(xb_ld(&bar[XB_XGEN(b.x)]) == gen, bar);
            __builtin_amdgcn_fence(__ATOMIC_ACQUIRE, "agent");
            asm volatile("s_waitcnt vmcnt(0)" ::: "memory");
        }
    }
    __syncthreads();
}

#ifndef REP_A
#define REP_A 1
#endif
#ifndef REP_C
#define REP_C 1
#endif
#ifndef REP_D
#define REP_D 1
#endif
#ifndef REP_F
#define REP_F 1
#endif
#ifndef REP_B
#define REP_B 1
#endif
#ifndef XSYNC
#define XSYNC 0
#endif
__global__ void __launch_bounds__(512, 2) fwd_megakernel(Args a) {
    extern __shared__ __attribute__((aligned(16))) unsigned char lds_raw[];
    cg::grid_group grid = cg::this_grid();
    LAS unsigned char* lds = (LAS unsigned char*)lds_raw;
    const int G = gridDim.x, bx = blockIdx.x;
    volatile LAS unsigned* MISC = (volatile LAS unsigned*)(lds + LDS_BYTES - 64);
    if (threadIdx.x < 16) MISC[threadIdx.x] = 0u;
    if (bx == 0) for (int u = threadIdx.x; u < XCD_BAR_WORDS; u += 512) ((unsigned*)a.ws)[u] = 0u;
    unsigned char* ws = a.ws;
    bf16_t* win_t = (bf16_t*)(ws + WS_WIN); bf16_t* wout_t = (bf16_t*)(ws + WS_WOUT); bf16_t* wfi_t = (bf16_t*)(ws + WS_WFI); bf16_t* wfo_t = (bf16_t*)(ws + WS_WFO);
    bf16_t* Z = (bf16_t*)(ws + WS_Z); bf16_t* H = Z; float* ZF = (float*)(ws + WS_ZF); bf16_t* SP = (bf16_t*)(ws + WS_ZF);
    bf16_t* XB = (bf16_t*)(ws + WS_XB); float* UT = (float*)(ws + WS_XB); bf16_t* MIX = (bf16_t*)(ws + WS_MIX); bf16_t* KT = (bf16_t*)(ws + WS_KT);
    float* SSQ = (float*)(ws + WS_SSQ); float* CS = (float*)(ws + WS_CS); float* KPM = (float*)(ws + WS_KPM); float* EM = (float*)(ws + WS_EM); float* EE = (float*)(ws + WS_EE);

#ifndef SKIP_P
    prologue(a, lds, G, bx);
#endif
    grid.sync();
    const XcdBarrier xbar = xcd_barrier_post((unsigned*)a.ws, MISC);
#define GSYNC() xcd_barrier(xbar)
#pragma unroll 1
    for (int l = 0; l < DEPTH; ++l) {
#ifndef SKIP_A
        for (int rep = 0; rep < REP_A; ++rep)
        { pg8::Gemm g{XB, win_t + (size_t)l * NIN * D, M, NIN, D}; pg8::StaticOrder S; S.init(M, NIN, G, bx); EpiIn E{Z, ZF, SSQ};
          pg8::gemm_phase<EpiIn, pg8::StaticOrder, true, true>(lds, g, S, E); }
#endif
        GSYNC();
#ifndef SKIP_B
        for (int rep = 0; rep < REP_B; ++rep) {
        for (int it = bx; it < 24 + 1024; it += G) {
            if (it < 24) attn_prep(lds, Z, ZF, a.fgate_b + l * 6, CS, KPM, it);
            else conv_item(lds, Z, a.conv_w + (size_t)l * 31 * 256, a.conv_b + l * 256, a.conv_ln_g + l * 256, a.conv_ln_b + l * 256, MIX, it - 24);
        }
        __syncthreads();
        { const int tid = opaque_tid(), lane = tid & 63, wid = __builtin_amdgcn_readfirstlane(tid >> 6);
          for (int it = bx * 8 + wid; it < NHITEM; it += G * 8) hgrn_a(lds + wid * 16384, Z, MIX, ZF, KT, a.lb_logits, l, UT, EM, EE, it, lane); }
        __syncthreads(); }
#endif
        GSYNC();
#ifndef SKIP_C
        for (int rep = 0; rep < REP_C; ++rep) {
        for (int it = bx; it < 192; it += G) hgrn_scan(UT, EM, EE, SP, it);
        for (int i = 0;; ++i) {
            const int pos = i * G + ((i & 1) ? (G - 1 - bx) : bx); if (pos >= 768) break;
            attn_unit(lds, Z, CS, KPM, MIX, pos % 24, 31 - pos / 24);
        }
        }
        for (int xs = 0; xs < XSYNC; ++xs) GSYNC();
#endif
        GSYNC();
#ifndef SKIP_D
        for (int rep = 0; rep < REP_D; ++rep)
        { const int tid = opaque_tid(), lane = tid & 63, wid = __builtin_amdgcn_readfirstlane(tid >> 6);
          for (int it = bx * 8 + wid; it < NHITEM; it += G * 8) hgrn_o(lds + wid * 16384, Z, KT, SP, a.hgrn_norm_g + l * 64, MIX, it, lane); }
#endif
        GSYNC();
#ifndef SKIP_E
        { pg8::Gemm g{MIX, wout_t + (size_t)l * D * D, M, D, D}; pg8::StaticOrder S; S.init(M, D, G, bx); EpiRes E{l == 0 ? a.x : a.out, a.out, XB, SSQ};
          pg8::gemm_phase<EpiRes, pg8::StaticOrder, true, true>(lds, g, S, E); }
#endif
        GSYNC();
#ifndef SKIP_F
        for (int rep = 0; rep < REP_F; ++rep)
        { pg8::Gemm g{XB, wfi_t + (size_t)l * NFF * D, M, NFF, D}; pg8::StaticOrder S; S.init(M, NFF, G, bx); EpiGlu E{H, SSQ};
          pg8::gemm_phase<EpiGlu, pg8::StaticOrder, true, true>(lds, g, S, E); }
#endif
        GSYNC();
#ifndef SKIP_G
        { pg8::Gemm g{H, wfo_t + (size_t)l * D * DFF, M, D, DFF}; pg8::StaticOrder S; S.init(M, D, G, bx); EpiRes E{a.out, a.out, XB, SSQ};
          pg8::gemm_phase<EpiRes, pg8::StaticOrder, true, true>(lds, g, S, E); }
#endif
        GSYNC();
    }
#ifndef SKIP_N
    final_norm(a, G, bx);
#endif
}

extern "C" void kernel_launch(void* const* d_in, const int* in_sizes, int n_in, void* d_out, int out_size, void* d_ws, size_t ws_size, hipStream_t stream) {
    static int grid = 0;
    if (grid == 0) {
        if (n_in != 15 || out_size != M * D || ws_size < WS_END) { fprintf(stderr, "kernel_launch: unexpected problem (n_in %d out %d ws %zu)\n", n_in, out_size, ws_size); grid = -1; return; }
        int dev = 0, cus = 0, per = 0;
        hipGetDevice(&dev); hipDeviceGetAttribute(&cus, hipDeviceAttributeMultiprocessorCount, dev);
        hipFuncSetAttribute((const void*)fwd_megakernel, hipFuncAttributeMaxDynamicSharedMemorySize, LDS_BYTES);
        if (hipOccupancyMaxActiveBlocksPerMultiprocessor(&per, (const void*)fwd_megakernel, 512, LDS_BYTES) != hipSuccess || per < 1) { fprintf(stderr, "kernel_launch: occupancy query gave %d\n", per); per = 1; }
        (void)hipGetLastError();
        grid = cus * per;
        fprintf(stderr, "kernel_launch: grid %d (cus %d x %d), ws %zu\n", grid, cus, per, ws_size);
    }
    if (grid < 0) return;
    Args a{};
    a.x = (const float*)d_in[0]; a.norm_mix_g = (const float*)d_in[1]; a.w_in = (const float*)d_in[2]; a.fgate_b = (const float*)d_in[3]; a.conv_w = (const float*)d_in[4];
    a.conv_b = (const float*)d_in[5]; a.conv_ln_g = (const float*)d_in[6]; a.conv_ln_b = (const float*)d_in[7]; a.lb_logits = (const float*)d_in[8]; a.hgrn_norm_g = (const float*)d_in[9];
    a.w_out = (const float*)d_in[10]; a.norm_ffn_g = (const float*)d_in[11]; a.w_ffn_in = (const float*)d_in[12]; a.w_ffn_out = (const float*)d_in[13]; a.norm_final_g = (const float*)d_in[14];
    a.out = (float*)d_out; a.ws = (unsigned char*)d_ws;
    void* args[] = {&a};
    hipError_t e = hipLaunchCooperativeKernel((const void*)fwd_megakernel, dim3(grid), dim3(512), args, LDS_BYTES, stream);
    if (e != hipSuccess) fprintf(stderr, "kernel_launch: cooperative launch failed: %s (grid %d)\n", hipGetErrorString(e), grid);
}
```

```cpp
#include <hip/hip_runtime.h>
#include <hip/hip_cooperative_groups.h>
#include <cstdio>
#include <cstdint>
namespace cg = cooperative_groups;
__device__ __forceinline__ int opaque_tid() { int t = threadIdx.x; asm volatile("" : "+v"(t)); return t; }
namespace pg8 {
#define PG8_LAS __attribute__((address_space(3)))
typedef unsigned short bf16_t;
typedef short bf16x8 __attribute__((ext_vector_type(8)));
typedef float f32x4 __attribute__((ext_vector_type(4)));
typedef unsigned u32x4 __attribute__((ext_vector_type(4)));
constexpr int BM = 256, BK = 64, HALF = 128, HTB = HALF * BK * 2  , STAGE_BYTES = 8 * HTB, NXCD = 8, WGM = 8;

__host__ __device__ __forceinline__ int lds_byte(int r, int c) { const int st = (r >> 4) * 2 + (c >> 5), rr = r & 15, cc = c & 31, ob = rr * 64 + cc * 2; return st * 1024 + (ob ^ (((ob >> 9) & 1) << 5)); }
__host__ __device__ __forceinline__ void stage_rc(int b, int& R, int& C) { const int st = b / 1024, sb = b % 1024, swz = sb ^ (((sb >> 9) & 1) << 5); R = (st >> 1) * 16 + swz / 64; C = (st & 1) * 32 + (swz % 64) / 2; }
__host__ __device__ __forceinline__ int perm32(int rho) { const int n = rho >> 4, i = rho & 15; return 8 * (i >> 2) + 4 * n + (i & 3); }

struct Unit { int pm, pn; };
struct Gemm { const bf16_t* A; const bf16_t* Bt; int M, N, K; };

struct StaticOrder {
    int nM, nN, nwg, G, c;
    __host__ __device__ void init(int M, int N, int G_, int c_) { nM = M / BM; nN = N / BM; nwg = nM * nN; G = G_; c = c_; }
    __host__ __device__ bool next(int i, Unit& u) const {
        const long L = (long)i * G + c; if (L >= nwg) return false;
        int wgid = (int)L; { const int q = nwg / NXCD, r = nwg % NXCD, xcd = wgid % NXCD, off = wgid / NXCD; wgid = (xcd < r ? xcd * (q + 1) : r * (q + 1) + (xcd - r) * q) + off; }
        const int nig = WGM * nN, gid = wgid / nig, fm = gid * WGM, gsz = (nM - fm) < WGM ? (nM - fm) : WGM;
        u.pm = fm + ((wgid % nig) % gsz); u.pn = (wgid % nig) / gsz; return true;
    }
    __device__ __forceinline__ void a_ready(const Unit&) const {}
    __device__ __forceinline__ void done(const Unit&) const {}
};

__device__ __forceinline__ unsigned cvt_pk_bf16(float lo, float hi) { unsigned r; asm volatile("v_cvt_pk_bf16_f32 %0, %1, %2" : "=v"(r) : "v"(lo), "v"(hi)); return r; }
typedef float f32x2 __attribute__((ext_vector_type(2)));
template <class Epi, class Sched, bool ALIGN_EPI = false, bool SP2 = false>
__device__ __forceinline__ void gemm_phase(PG8_LAS unsigned char* lds, const Gemm g, const Sched& S, const Epi& E) {
    const int tid = opaque_tid(), wid = __builtin_amdgcn_readfirstlane(tid >> 6), lane = tid & 63, wr = wid >> 2, wc = wid & 3, fr = lane & 15, fq = lane >> 4;
    const int K = g.K, nt = K / BK;
    unsigned voffA[2], voffB[2];
#pragma unroll
    for (int i = 0; i < 2; ++i) { int R, C; stage_rc(tid * 16 + i * 8192, R, C); const int Rb = Epi::PERM ? ((R & ~31) + perm32(R & 31)) : R;
        voffA[i] = (unsigned)(R * K + C) * 2u; voffB[i] = (unsigned)(Rb * K + C) * 2u; }
    const size_t kstep = (size_t)(BK * 2);
    const size_t hstep = (size_t)HALF * K * 2;
    const size_t tstep = 2 * hstep;
    const unsigned ldsw = (unsigned)wid * 1024u;
    const int aoff = lds_byte(wr * 64 + fr, fq * 8), boff = lds_byte(wc * 32 + fr, fq * 8);
#define PG8_SA(b, h) (((b) * 2 + (h)) * HTB)
#define PG8_SB(b, h) ((4 + (b) * 2 + (h)) * HTB)
#define PG8_STAGE(bufoff, gbase, voff) do { _Pragma("unroll") for (int _i = 0; _i < 2; ++_i) \
        __builtin_amdgcn_global_load_lds((const unsigned*)((const char*)(gbase) + (voff)[_i]), (PG8_LAS unsigned*)(lds + (bufoff) + ldsw + _i * 8192), 16, 0, 0); } while (0)
#define PG8_LDA(dst, b, h) do { _Pragma("unroll") for (int m = 0; m < 4; ++m) _Pragma("unroll") for (int k = 0; k < 2; ++k) dst[m][k] = *(const PG8_LAS bf16x8*)(lds + PG8_SA(b, h) + aoff + m * 2048 + k * 1024); } while (0)
#define PG8_LDB(dst, b, h) do { _Pragma("unroll") for (int n = 0; n < 2; ++n) _Pragma("unroll") for (int k = 0; k < 2; ++k) dst[n][k] = *(const PG8_LAS bf16x8*)(lds + PG8_SB(b, h) + boff + n * 2048 + k * 1024); } while (0)
#define PG8_MMA(ai, bj, At, Bt) do { __builtin_amdgcn_s_setprio(1); _Pragma("unroll") for (int m = 0; m < 4; ++m) _Pragma("unroll") for (int n = 0; n < 2; ++n) _Pragma("unroll") for (int k = 0; k < 2; ++k) \
        acc[ai][bj][m][n] = __builtin_amdgcn_mfma_f32_16x16x32_bf16(Bt[n][k], At[m][k], acc[ai][bj][m][n], 0, 0, 0); __builtin_amdgcn_s_setprio(0); } while (0)
#define PG8_WAIT_V(n) asm volatile("s_waitcnt vmcnt(" #n ")" ::: "memory")
#define PG8_WAIT_L(n) asm volatile("s_waitcnt lgkmcnt(" #n ")" ::: "memory")
#define PG8_BAR __builtin_amdgcn_s_barrier()
#define PG8_SCHED __builtin_amdgcn_sched_barrier(0)
    Unit cur, nxt; int ui = 0;
    if (!S.next(0, cur)) return;
    f32x4 acc[2][2][4][2];
#pragma unroll
    for (int a = 0; a < 2; ++a)
#pragma unroll
        for (int b = 0; b < 2; ++b)
#pragma unroll
            for (int m = 0; m < 4; ++m)
#pragma unroll
                for (int n = 0; n < 2; ++n) acc[a][b][m][n] = (f32x4){0.f, 0.f, 0.f, 0.f};
    bf16x8 At[4][2], B0[2][2], B1[2][2];
    const char* cA = (const char*)g.A + (size_t)cur.pm * tstep; const char* cB = (const char*)g.Bt + (size_t)cur.pn * tstep;
    S.a_ready(cur);
    if constexpr (SP2) {
        PG8_STAGE(PG8_SB(0, 0), cB, voffB); PG8_STAGE(PG8_SB(0, 1), cB + hstep, voffB); PG8_STAGE(PG8_SA(0, 0), cA, voffA); PG8_STAGE(PG8_SA(0, 1), cA + hstep, voffA);
        if (wr == 1) PG8_BAR;
        PG8_WAIT_V(2); PG8_BAR;
        PG8_STAGE(PG8_SB(1, 0), cB + kstep, voffB); PG8_STAGE(PG8_SA(1, 0), cA + kstep, voffA); PG8_STAGE(PG8_SB(1, 1), cB + hstep + kstep, voffB);
        PG8_WAIT_V(6); PG8_BAR;
    } else {
        PG8_STAGE(PG8_SB(0, 0), cB, voffB); PG8_STAGE(PG8_SA(0, 0), cA, voffA); PG8_STAGE(PG8_SB(0, 1), cB + hstep, voffB); PG8_STAGE(PG8_SA(0, 1), cA + hstep, voffA);
        if (wr == 1) PG8_BAR;
        PG8_WAIT_V(4); PG8_BAR;
        PG8_STAGE(PG8_SB(1, 0), cB + kstep, voffB); PG8_STAGE(PG8_SA(1, 0), cA + kstep, voffA); PG8_STAGE(PG8_SB(1, 1), cB + hstep + kstep, voffB);
        PG8_WAIT_V(6); PG8_BAR;
    }
    for (;;) {
        const bool has_next = S.next(ui + 1, nxt);
        const char* nA = has_next ? (const char*)g.A + (size_t)nxt.pm * tstep : cA; const char* nB = has_next ? (const char*)g.Bt + (size_t)nxt.pn * tstep : cB;
        for (int t = 0; t < nt; t += 2) {
            const bool last = (t == nt - 2);
            const char* a1 = cA + (size_t)(t + 1) * kstep;
            const char* a2 = last ? nA : cA + (size_t)(t + 2) * kstep; const char* b2 = last ? nB : cB + (size_t)(t + 2) * kstep;
            const char* a3 = a2 + kstep; const char* b3 = b2 + kstep;
            if (last && has_next) S.a_ready(nxt);
            if constexpr (SP2) {
            PG8_LDB(B0, 0, 0); PG8_LDB(B1, 0, 1); PG8_SCHED; PG8_LDA(At, 0, 0); PG8_STAGE(PG8_SA(1, 1), a1 + hstep, voffA);
            PG8_WAIT_V(8); PG8_WAIT_L(0); PG8_BAR; PG8_MMA(0, 0, At, B0); PG8_MMA(0, 1, At, B1); PG8_BAR; PG8_SCHED;
            PG8_LDA(At, 0, 1); PG8_STAGE(PG8_SB(0, 0), b2, voffB); PG8_STAGE(PG8_SB(0, 1), b2 + hstep, voffB); PG8_STAGE(PG8_SA(0, 0), a2, voffA);
            PG8_WAIT_V(8); PG8_WAIT_L(0); PG8_BAR; PG8_MMA(1, 0, At, B0); PG8_MMA(1, 1, At, B1); PG8_BAR; PG8_SCHED;
            PG8_LDB(B0, 1, 0); PG8_LDB(B1, 1, 1); PG8_SCHED; PG8_LDA(At, 1, 0); PG8_STAGE(PG8_SA(0, 1), a2 + hstep, voffA);
            PG8_WAIT_V(8); PG8_WAIT_L(0); PG8_BAR; PG8_MMA(0, 0, At, B0); PG8_MMA(0, 1, At, B1); PG8_BAR; PG8_SCHED;
            PG8_LDA(At, 1, 1); PG8_STAGE(PG8_SB(1, 0), b3, voffB); PG8_STAGE(PG8_SB(1, 1), b3 + hstep, voffB); PG8_STAGE(PG8_SA(1, 0), a3, voffA);
            PG8_WAIT_V(8); PG8_WAIT_L(0); PG8_BAR; PG8_MMA(1, 0, At, B0); PG8_MMA(1, 1, At, B1); PG8_BAR; PG8_SCHED;
            } else {
            PG8_LDB(B0, 0, 0); PG8_SCHED; PG8_LDA(At, 0, 0); PG8_STAGE(PG8_SA(1, 1), a1 + hstep, voffA);
            PG8_WAIT_L(8); PG8_BAR; PG8_WAIT_L(0); PG8_MMA(0, 0, At, B0); PG8_BAR; PG8_SCHED;
            PG8_LDB(B1, 0, 1); PG8_STAGE(PG8_SB(0, 0), b2, voffB);
            PG8_BAR; PG8_WAIT_L(0); PG8_MMA(0, 1, At, B1); PG8_BAR;
            PG8_LDA(At, 0, 1); PG8_STAGE(PG8_SA(0, 0), a2, voffA);
            PG8_BAR; PG8_WAIT_L(0); PG8_MMA(1, 0, At, B0); PG8_BAR; PG8_SCHED;
            PG8_STAGE(PG8_SB(0, 1), b2 + hstep, voffB);
            PG8_WAIT_V(6); PG8_BAR; PG8_MMA(1, 1, At, B1); PG8_BAR;
            PG8_LDB(B0, 1, 0); PG8_SCHED; PG8_LDA(At, 1, 0); PG8_STAGE(PG8_SA(0, 1), a2 + hstep, voffA);
            PG8_WAIT_L(8); PG8_BAR; PG8_WAIT_L(0); PG8_MMA(0, 0, At, B0); PG8_BAR; PG8_SCHED;
            PG8_LDB(B1, 1, 1); PG8_STAGE(PG8_SB(1, 0), b3, voffB);
            PG8_BAR; PG8_WAIT_L(0); PG8_MMA(0, 1, At, B1); PG8_BAR;
            PG8_LDA(At, 1, 1); PG8_STAGE(PG8_SA(1, 0), a3, voffA);
            PG8_BAR; PG8_WAIT_L(0); PG8_MMA(1, 0, At, B0); PG8_BAR; PG8_SCHED;
            PG8_STAGE(PG8_SB(1, 1), b3 + hstep, voffB);
            PG8_WAIT_V(6); PG8_BAR; PG8_MMA(1, 1, At, B1); PG8_BAR;
            }
        }
        if constexpr (ALIGN_EPI) { if (wr == 0) PG8_BAR; }
        if constexpr (!Epi::AFTER_DRAIN) { E(acc, cur, wr, wc, fr, fq); S.done(cur); }
        if (!has_next) break;
#pragma unroll
        for (int a = 0; a < 2; ++a)
#pragma unroll
            for (int b = 0; b < 2; ++b)
#pragma unroll
                for (int m = 0; m < 4; ++m)
#pragma unroll
                    for (int n = 0; n < 2; ++n) acc[a][b][m][n] = (f32x4){0.f, 0.f, 0.f, 0.f};
        cur = nxt; cA = nA; cB = nB; ++ui;
        if constexpr (ALIGN_EPI) { if (wr == 1) PG8_BAR; }
    }
    PG8_WAIT_V(0);
    if constexpr (!ALIGN_EPI) { if (wr == 0) PG8_BAR; }
    PG8_BAR;
    if constexpr (Epi::AFTER_DRAIN) { E.fused(acc, cur, wr, wc, fr, fq, lds, wid, lane); S.done(cur); }
#undef PG8_SA
#undef PG8_SB
#undef PG8_STAGE
#undef PG8_LDA
#undef PG8_LDB
#undef PG8_MMA
#undef PG8_WAIT_V
#undef PG8_WAIT_L
#undef PG8_BAR
#undef PG8_SCHED
}
}
#define LAS __attribute__((address_space(3)))
typedef unsigned short bf16_t;
typedef short bf16x8 __attribute__((ext_vector_type(8)));
typedef short s16x4 __attribute__((ext_vector_type(4)));
typedef float f32x4 __attribute__((ext_vector_type(4)));
typedef float f32x16 __attribute__((ext_vector_type(16)));
typedef unsigned u32x4 __attribute__((ext_vector_type(4)));
typedef unsigned u32x2 __attribute__((ext_vector_type(2)));
typedef float f32x2_t __attribute__((ext_vector_type(2)));
typedef __bf16 bf16x2_t __attribute__((ext_vector_type(2)));

constexpr int NBATCH = 4, T = 8192, D = 1024, DEPTH = 4, M = NBATCH * T;
constexpr int DIN = 3206, NIN = 3328, DFF = 2816, NFF = 5632;
constexpr int ZP = 2816, ZFP = 512;
constexpr int Z_QA = 0, Z_KA = 384, Z_VA = 768, Z_CV = 1152, Z_QH = 1664, Z_IH = 2048, Z_GH = 2432;
constexpr int ZF_FH = 0, ZF_FA = 384;
constexpr int MIX_ATT = 0, MIX_CNV = 384, MIX_HG = 640;
constexpr float LOG2E = 1.4426950408889634f;
constexpr float QSCALE = 0.125f * LOG2E;
constexpr int NHITEM = NBATCH * 6 * 128;
constexpr size_t MiB = 1u << 20;
constexpr size_t WS_WIN = 1 * MiB, WS_WOUT = 27 * MiB, WS_WFI = 35 * MiB, WS_WFO = 79 * MiB, WS_Z = 101 * MiB, WS_ZF = 277 * MiB, WS_XB = 341 * MiB,
                 WS_MIX = 405 * MiB, WS_KT = 469 * MiB, WS_SSQ = 493 * MiB, WS_CS = 495 * MiB, WS_KPM = 496 * MiB, WS_EM = 497 * MiB, WS_EE = 498 * MiB, WS_END = 499 * MiB;
constexpr int LDS_BYTES = 135168;

struct Args {
    const float *x, *norm_mix_g, *w_in, *fgate_b, *conv_w, *conv_b, *conv_ln_g, *conv_ln_b, *lb_logits, *hgrn_norm_g, *w_out, *norm_ffn_g, *w_ffn_in, *w_ffn_out, *norm_final_g;
    float* out; unsigned char* ws;
};

__device__ __forceinline__ unsigned cvtpk(float lo, float hi) { f32x2_t v = {lo, hi}; bf16x2_t b = __builtin_convertvector(v, bf16x2_t); return __builtin_bit_cast(unsigned, b); }
__device__ __forceinline__ float bf2f(unsigned short u) { return __uint_as_float((unsigned)u << 16); }
__device__ __forceinline__ float bflo(unsigned u) { return __uint_as_float(u << 16); }
__device__ __forceinline__ float bfhi(unsigned u) { return __uint_as_float(u & 0xffff0000u); }
__device__ __forceinline__ unsigned short f2bf(float f) { return (unsigned short)(cvtpk(f, 0.f) & 0xffffu); }
__device__ __forceinline__ float fast_rcp(float x) { return __builtin_amdgcn_rcpf(x); }
__device__ __forceinline__ float sigmoidf_(float x) { return fast_rcp(1.f + __expf(-x)); }
__device__ __forceinline__ float siluf_(float x) { return x * fast_rcp(1.f + __expf(-x)); }
__device__ __forceinline__ int crow(int r, int hi) { return (r & 3) + 8 * (r >> 2) + 4 * hi; }
__device__ __forceinline__ s16x4 trread(const LAS unsigned char* p) { typedef short v4i16_t __attribute__((ext_vector_type(4))); return __builtin_bit_cast(s16x4, __builtin_amdgcn_ds_read_tr16_b64_v4i16((LAS v4i16_t*)p)); }
__device__ __forceinline__ bf16x8 cat8(s16x4 lo, s16x4 hi) { return (bf16x8){lo[0], lo[1], lo[2], lo[3], hi[0], hi[1], hi[2], hi[3]}; }
__device__ __forceinline__ float wave_sum(float v) {
#pragma unroll
    for (int o = 1; o < 64; o <<= 1) v += __shfl_xor(v, o);
    return v;
}

__device__ __forceinline__ float row_rstd(const float* ssq, int row, int fq) {
    const f32x4 p = *(const f32x4*)(ssq + (size_t)row * 16 + 4 * fq);
    float s = (p[0] + p[1]) + (p[2] + p[3]); s += __shfl_xor(s, 16); s += __shfl_xor(s, 32);
    return rsqrtf(s * (1.0f / D) + 1e-6f);
}
struct EpiIn {
    static constexpr bool PERM = true, AFTER_DRAIN = false;
    bf16_t* Z; float* ZF; const float* ssq;
    __device__ __forceinline__ void operator()(const pg8::f32x4 (&acc)[2][2][4][2], const pg8::Unit& u, int wr, int wc, int fr, int fq) const {
        const int row0 = u.pm * 256 + wr * 64 + fr, col0 = u.pn * 256 + wc * 32 + 8 * fq;
        float rsv[2][4];
#pragma unroll
        for (int ai = 0; ai < 2; ++ai)
#pragma unroll
            for (int m = 0; m < 4; ++m) rsv[ai][m] = row_rstd(ssq, row0 + ai * 128 + m * 16, fq);
        asm volatile("" ::: "memory");
#pragma unroll
        for (int ai = 0; ai < 2; ++ai)
#pragma unroll
            for (int m = 0; m < 4; ++m) {
                const int row = row0 + ai * 128 + m * 16; const float rs = rsv[ai][m];
#pragma unroll
                for (int bj = 0; bj < 2; ++bj) {
                    const f32x4 v0 = acc[ai][bj][m][0] * rs, v1 = acc[ai][bj][m][1] * rs; const int c = col0 + bj * 128;
                    if (u.pn < 11) { u32x4 w; w.x = cvtpk(v0[0], v0[1]); w.y = cvtpk(v0[2], v0[3]); w.z = cvtpk(v1[0], v1[1]); w.w = cvtpk(v1[2], v1[3]); *(u32x4*)(Z + (size_t)row * ZP + c) = w; }
                    else { float* p = ZF + (size_t)row * ZFP + (c - 2816); *(f32x4*)p = v0; *(f32x4*)(p + 4) = v1; }
                }
            }
    }
};
struct EpiRes {
    static constexpr bool PERM = true, AFTER_DRAIN = false;
    const float* base; float* out; bf16_t* xb; float* ssq;
    __device__ __forceinline__ void operator()(const pg8::f32x4 (&acc)[2][2][4][2], const pg8::Unit& u, int wr, int wc, int fr, int fq) const {
        const int row0 = u.pm * 256 + wr * 64 + fr, col0 = u.pn * 256 + wc * 32 + 8 * fq;
#pragma unroll
        for (int ai = 0; ai < 2; ++ai) {
            f32x4 bv[4][2][2];
#pragma unroll
            for (int m = 0; m < 4; ++m)
#pragma unroll
                for (int bj = 0; bj < 2; ++bj) { const size_t off = (size_t)(row0 + ai * 128 + m * 16) * D + col0 + bj * 128; bv[m][bj][0] = *(const f32x4*)(base + off); bv[m][bj][1] = *(const f32x4*)(base + off + 4); }
            asm volatile("" ::: "memory");
#pragma unroll
            for (int m = 0; m < 4; ++m) {
                const int row = row0 + ai * 128 + m * 16; float q = 0.f;
#pragma unroll
                for (int bj = 0; bj < 2; ++bj) {
                    const size_t off = (size_t)row * D + col0 + bj * 128;
                    const f32x4 v0 = acc[ai][bj][m][0] + bv[m][bj][0], v1 = acc[ai][bj][m][1] + bv[m][bj][1];
                    *(f32x4*)(out + off) = v0; *(f32x4*)(out + off + 4) = v1;
                    u32x4 w; w.x = cvtpk(v0[0], v0[1]); w.y = cvtpk(v0[2], v0[3]); w.z = cvtpk(v1[0], v1[1]); w.w = cvtpk(v1[2], v1[3]); *(u32x4*)(xb + off) = w;
                    q += (v0[0] * v0[0] + v0[1] * v0[1]) + (v0[2] * v0[2] + v0[3] * v0[3]) + (v1[0] * v1[0] + v1[1] * v1[1]) + (v1[2] * v1[2] + v1[3] * v1[3]);
                }
                q += __shfl_xor(q, 16); q += __shfl_xor(q, 32);
                if (fq == 0) ssq[(size_t)row * 16 + u.pn * 4 + wc] = q;
            }
            asm volatile("" ::: "memory");
        }
    }
};
struct EpiGlu {
    static constexpr bool PERM = true, AFTER_DRAIN = false;
    bf16_t* H; const float* ssq;
    __device__ __forceinline__ void operator()(const pg8::f32x4 (&acc)[2][2][4][2], const pg8::Unit& u, int wr, int wc, int fr, int fq) const {
        const int row0 = u.pm * 256 + wr * 64 + fr, col0 = u.pn * 128 + wc * 32 + 8 * fq;
        float rsv[2][4];
#pragma unroll
        for (int ai = 0; ai < 2; ++ai)
#pragma unroll
            for (int m = 0; m < 4; ++m) rsv[ai][m] = row_rstd(ssq, row0 + ai * 128 + m * 16, fq);
        asm volatile("" ::: "memory");
#pragma unroll
        for (int ai = 0; ai < 2; ++ai)
#pragma unroll
            for (int m = 0; m < 4; ++m) {
                const int row = row0 + ai * 128 + m * 16; const float rs = rsv[ai][m];
                float hv[8];
#pragma unroll
                for (int n = 0; n < 2; ++n)
#pragma unroll
                    for (int e = 0; e < 4; ++e) { const float g = acc[ai][0][m][n][e] * rs, up = acc[ai][1][m][n][e] * rs; hv[n * 4 + e] = siluf_(g) * up; }
                u32x4 w; w.x = cvtpk(hv[0], hv[1]); w.y = cvtpk(hv[2], hv[3]); w.z = cvtpk(hv[4], hv[5]); w.w = cvtpk(hv[6], hv[7]);
                *(u32x4*)(H + (size_t)row * DFF + col0) = w;
            }
    }
};
__device__ __forceinline__ int map_win(int n) {
    if (n < 1152) return n;
    if (n < 1158) return 3200 + (n - 1152);
    if (n < 1670) return Z_CV + (n - 1158);
    if (n < 2054) return Z_QH + (n - 1670);
    if (n < 2438) return 2816 + (n - 2054);
    if (n < 2822) return Z_IH + (n - 2438);
    return Z_GH + (n - 2822);
}
template <int MODE>
__device__ __forceinline__ void transpose_item(const float* W, int K, int N, bf16_t* WT, const float* gs, LAS float* scr, int item, int lane) {
    const int nblk = (N + 31) / 32, kb = item / nblk, nb = item % nblk, k0 = 64 * kb, n0 = 32 * nb;
    const int nn = n0 + (lane & 31);
    float tv[32];
#pragma unroll
    for (int i = 0; i < 32; ++i) { const int kk = 2 * i + (lane >> 5); tv[i] = (nn < N) ? W[(size_t)(k0 + kk) * N + nn] : 0.f; }
    const int c = lane & 7;
    f32x4 g0 = {1.f, 1.f, 1.f, 1.f}, g1 = g0;
    if (gs) { g0 = *(const f32x4*)(gs + k0 + 8 * c); g1 = *(const f32x4*)(gs + k0 + 8 * c + 4); }
#pragma unroll
    for (int i = 0; i < 32; ++i) scr[(2 * i + (lane >> 5)) * 33 + (lane & 31)] = tv[i];
    asm volatile("s_waitcnt lgkmcnt(0)" ::: "memory");
#pragma unroll
    for (int j = 0; j < 4; ++j) {
        const int nl = (lane >> 3) + 8 * j, n = n0 + nl; const LAS float* s = scr + (8 * c) * 33 + nl;
        if (n < N) {
            int row; float sc = 1.f;
            if (MODE == 0) { row = map_win(n); if (n < 384) sc = QSCALE; }
            else if (MODE == 2) { row = (n < DFF) ? ((n >> 7) * 256 + (n & 127)) : ((((n - DFF) >> 7) * 256) + 128 + ((n - DFF) & 127)); }
            else row = n;
            u32x4 o; o.x = cvtpk(s[0 * 33] * (sc * g0[0]), s[1 * 33] * (sc * g0[1])); o.y = cvtpk(s[2 * 33] * (sc * g0[2]), s[3 * 33] * (sc * g0[3]));
            o.z = cvtpk(s[4 * 33] * (sc * g1[0]), s[5 * 33] * (sc * g1[1])); o.w = cvtpk(s[6 * 33] * (sc * g1[2]), s[7 * 33] * (sc * g1[3]));
            *(u32x4*)(WT + (size_t)row * K + k0 + 8 * c) = o;
        }
    }
    asm volatile("s_waitcnt lgkmcnt(0)" ::: "memory");
}
__device__ __forceinline__ void prologue(const Args& a, LAS unsigned char* lds, int G, int bx) {
    const int tid = opaque_tid(), lane = tid & 63, wid = __builtin_amdgcn_readfirstlane(tid >> 6), gw = bx * 8 + wid, NGW = G * 8;
    LAS float* scr = (LAS float*)(lds + wid * 16384);
    constexpr int I_IN = 16 * 101, I_OUT = 16 * 32, I_FI = 16 * 176, I_FO = 44 * 32, I_L = I_IN + I_OUT + I_FI + I_FO;
    for (int it = gw; it < DEPTH * I_L; it += NGW) {
        const int l = it / I_L; int r = it % I_L;
        if (r < I_IN) { transpose_item<0>(a.w_in + (size_t)l * D * DIN, D, DIN, (bf16_t*)(a.ws + WS_WIN) + (size_t)l * NIN * D, a.norm_mix_g + l * D, scr, r, lane); continue; } r -= I_IN;
        if (r < I_OUT) { transpose_item<1>(a.w_out + (size_t)l * D * D, D, D, (bf16_t*)(a.ws + WS_WOUT) + (size_t)l * D * D, nullptr, scr, r, lane); continue; } r -= I_OUT;
        if (r < I_FI) { transpose_item<2>(a.w_ffn_in + (size_t)l * D * NFF, D, NFF, (bf16_t*)(a.ws + WS_WFI) + (size_t)l * NFF * D, a.norm_ffn_g + l * D, scr, r, lane); continue; } r -= I_FI;
        transpose_item<1>(a.w_ffn_out + (size_t)l * DFF * D, DFF, D, (bf16_t*)(a.ws + WS_WFO) + (size_t)l * D * DFF, nullptr, scr, r, lane);
    }
    bf16_t* xb = (bf16_t*)(a.ws + WS_XB); float* ssq = (float*)(a.ws + WS_SSQ);
    for (int m = gw; m < M; m += NGW) {
        const f32x4* xr = (const f32x4*)(a.x + (size_t)m * D) + lane; float s = 0.f;
        u32x2* o8 = (u32x2*)(xb + (size_t)m * D) + lane;
#pragma unroll
        for (int j = 0; j < 4; ++j) { const f32x4 v = xr[64 * j]; s += (v[0] * v[0] + v[1] * v[1]) + (v[2] * v[2] + v[3] * v[3]); u32x2 w; w.x = cvtpk(v[0], v[1]); w.y = cvtpk(v[2], v[3]); o8[64 * j] = w; }
        s = wave_sum(s);
        if (lane < 16) ssq[(size_t)m * 16 + lane] = (lane == 0) ? s : 0.f;
    }
}
__device__ __forceinline__ void final_norm(const Args& a, int G, int bx) {
    const int tid = opaque_tid(), lane = tid & 63, wid = __builtin_amdgcn_readfirstlane(tid >> 6), gw = bx * 8 + wid, NGW = G * 8;
    for (int m = gw; m < M; m += NGW) {
        f32x4* xr = (f32x4*)(a.out + (size_t)m * D) + lane; const f32x4* gr = (const f32x4*)a.norm_final_g + lane;
        f32x4 v[4]; float s = 0.f;
#pragma unroll
        for (int j = 0; j < 4; ++j) { v[j] = xr[64 * j]; s += (v[j][0] * v[j][0] + v[j][1] * v[j][1]) + (v[j][2] * v[j][2] + v[j][3] * v[j][3]); }
        const float rs = rsqrtf(wave_sum(s) * (1.f / D) + 1e-6f);
#pragma unroll
        for (int j = 0; j < 4; ++j) xr[64 * j] = v[j] * rs * gr[64 * j];
    }
}

__device__ __forceinline__ void attn_prep(LAS unsigned char* L, const bf16_t* Z, const float* ZF, const float* fgb, float* cs, float* kpm, int bh) {
    const int tid = opaque_tid(), lane = tid & 63, wid = tid >> 6, b = bh / 6, h = bh % 6;
    LAS float* wtot = (LAS float*)L;
    LAS float* tm = (LAS float*)(L + 64);
    LAS float* tl = (LAS float*)(L + 64 + 2048);
    const float fb = fgb[h];
    float lf[16]; float s = 0.f;
    const size_t r0 = (size_t)b * T + 16 * tid;
#pragma unroll
    for (int i = 0; i < 16; ++i) { const float x = ZF[(r0 + i) * ZFP + ZF_FA + h] + fb; lf[i] = fminf(x, 0.f) - log1pf(__expf(-fabsf(x))); s += lf[i]; }
    float inc = s;
#pragma unroll
    for (int o = 1; o < 64; o <<= 1) { const float t = __shfl_up(inc, o); if (lane >= o) inc += t; }
    if (lane == 63) wtot[wid] = inc;
    float mx = 0.f;
#pragma unroll 4
    for (int i = 0; i < 16; ++i) {
        const u32x4* kp = (const u32x4*)(Z + (r0 + i) * ZP + Z_KA + h * 64); float n2 = 0.f;
#pragma unroll
        for (int c = 0; c < 8; ++c) { const u32x4 w = kp[c];
#pragma unroll
            for (int e = 0; e < 4; ++e) { const float lo = bflo(w[e]), hi = bfhi(w[e]); n2 += lo * lo + hi * hi; } }
        mx = fmaxf(mx, n2);
    }
    tm[tid] = mx;
    __syncthreads();
    float run = inc - s;
    for (int w = 0; w < wid; ++w) run += wtot[w];
#pragma unroll
    for (int i = 0; i < 16; ++i) { run += lf[i]; cs[(size_t)bh * T + 16 * tid + i] = run; }
    if (tid < 128) tl[tid] = fmaxf(fmaxf(tm[4 * tid], tm[4 * tid + 1]), fmaxf(tm[4 * tid + 2], tm[4 * tid + 3]));
    __syncthreads();
    if (tid < 128) { float p = 0.f; for (int i = 0; i <= tid; ++i) p = fmaxf(p, tl[i]); kpm[bh * 128 + tid] = p; }
    __syncthreads();
}

constexpr int AK_STR = 144, AV_STR = 192, AK_BYTES = 64 * AK_STR, AV_BYTES = 64 * AV_STR, A_VOFF = 2 * AK_BYTES, A_BOFF = A_VOFF + 2 * AV_BYTES, A_VOTE = A_BOFF + 512;
__device__ __forceinline__ void attn_unit(LAS unsigned char* L, const bf16_t* Z, const float* cs, const float* kpm, bf16_t* MIX, int bh, int qb) {
    const int tid = opaque_tid(), lane = tid & 63, r32 = lane & 31, hi = lane >> 5; const int wid = __builtin_amdgcn_readfirstlane(tid >> 6);
    const int b = bh / 6, h = bh % 6; const size_t rowbase = (size_t)b * T; const int q0 = qb * 256, t0 = q0 + wid * 32;
    bf16x8 qr[4];
    { const bf16_t* Qp = Z + (rowbase + t0 + r32) * ZP + Z_QA + h * 64 + hi * 8;
#pragma unroll
      for (int d0 = 0; d0 < 4; ++d0) qr[d0] = *(const bf16x8*)(Qp + d0 * 16); }
    float qn2 = 0.f;
#pragma unroll
    for (int d0 = 0; d0 < 4; ++d0)
#pragma unroll
        for (int e = 0; e < 8; ++e) { const float v = bf2f((unsigned short)qr[d0][e]); qn2 += v * v; }
    qn2 += __shfl_xor(qn2, 32);
    const float qn = sqrtf(qn2) * 1.001f;
    const float* csb = cs + (size_t)bh * T; const float cref = csb[q0];
    const int srow = tid >> 3, sch = tid & 7;
    const bf16_t* Kg = Z + rowbase * ZP + Z_KA + h * 64 + sch * 8; const bf16_t* Vg = Z + rowbase * ZP + Z_VA + h * 64 + sch * 8;
    int j = (q0 + 256) / 64 - 1;
    u32x4 kreg = *(const u32x4*)(Kg + (size_t)(64 * j + srow) * ZP), vreg = *(const u32x4*)(Vg + (size_t)(64 * j + srow) * ZP);
    float cval = (tid < 64) ? csb[64 * j + tid] : 0.f;
    *(LAS u32x4*)(L + srow * AK_STR + sch * 16) = kreg; *(LAS u32x4*)(L + A_VOFF + srow * AV_STR + sch * 16) = vreg;
    if (tid < 64) ((LAS float*)(L + A_BOFF))[tid] = (cref - cval) * LOG2E;
    __syncthreads();
    float m = -1e30f, l = 0.f; f32x16 o[2]; o[0] = f32x16{}; o[1] = f32x16{};
    int buf = 0;
    const int tq = (lane & 15) >> 2, tp = lane & 3, tg1 = (lane >> 4) & 1;
    for (;;) {
        const bool more = j > 0;
        if (more) { kreg = *(const u32x4*)(Kg + (size_t)(64 * (j - 1) + srow) * ZP); vreg = *(const u32x4*)(Vg + (size_t)(64 * (j - 1) + srow) * ZP); cval = (tid < 64) ? csb[64 * (j - 1) + tid] : 0.f; }
        const int k0 = 64 * j;
        if (k0 <= t0 + 31) {
            const LAS unsigned char* Kb = L + buf * AK_BYTES; const LAS unsigned char* Vb = L + A_VOFF + buf * AV_BYTES;
            const LAS float* kbp = (const LAS float*)(L + A_BOFF + buf * 256) + 4 * hi;
            f32x16 p0, p1;
#pragma unroll
            for (int i = 0; i < 4; ++i) { const f32x4 ta = *(const LAS f32x4*)(kbp + 8 * i), tb = *(const LAS f32x4*)(kbp + 32 + 8 * i);
#pragma unroll
                for (int e = 0; e < 4; ++e) { p0[4 * i + e] = ta[e]; p1[4 * i + e] = tb[e]; } }
#pragma unroll
            for (int d0 = 0; d0 < 4; ++d0) {
                const bf16x8 a0 = *(const LAS bf16x8*)(Kb + r32 * AK_STR + d0 * 32 + hi * 16), a1 = *(const LAS bf16x8*)(Kb + (32 + r32) * AK_STR + d0 * 32 + hi * 16);
                p0 = __builtin_amdgcn_mfma_f32_32x32x16_bf16(a0, qr[d0], p0, 0, 0, 0); p1 = __builtin_amdgcn_mfma_f32_32x32x16_bf16(a1, qr[d0], p1, 0, 0, 0);
            }
            if (k0 + 63 > t0) { const int tt = t0 + r32;
#pragma unroll
                for (int r = 0; r < 16; ++r) { const int kv = k0 + crow(r, hi); if (kv > tt) p0[r] = -INFINITY; if (kv + 32 > tt) p1[r] = -INFINITY; } }
            float mx = fmaxf(p0[0], p1[0]);
#pragma unroll
            for (int r = 1; r < 16; ++r) mx = fmaxf(mx, fmaxf(p0[r], p1[r]));
            mx = fmaxf(mx, __shfl_xor(mx, 32));
            const float mnew = fmaxf(m, mx), alpha = __builtin_amdgcn_exp2f(m - mnew);
            float sum = 0.f;
#pragma unroll
            for (int r = 0; r < 16; ++r) { p0[r] = __builtin_amdgcn_exp2f(p0[r] - mnew); p1[r] = __builtin_amdgcn_exp2f(p1[r] - mnew); sum += p0[r] + p1[r]; }
            l = l * alpha + sum; m = mnew;
#pragma unroll
            for (int r = 0; r < 16; ++r) { o[0][r] *= alpha; o[1][r] *= alpha; }
            u32x4 pw[4];
#pragma unroll
            for (int e = 0; e < 4; ++e) { pw[0][e] = cvtpk(p0[2 * e], p0[2 * e + 1]); pw[1][e] = cvtpk(p0[8 + 2 * e], p0[9 + 2 * e]); pw[2][e] = cvtpk(p1[2 * e], p1[2 * e + 1]); pw[3][e] = cvtpk(p1[8 + 2 * e], p1[9 + 2 * e]); }
#pragma unroll
            for (int dh = 0; dh < 2; ++dh)
#pragma unroll
                for (int s = 0; s < 4; ++s) {
                    const LAS unsigned char* ap = Vb + (16 * s + 4 * hi + tq) * AV_STR + (32 * dh + 16 * tg1 + 4 * tp) * 2;
                    const bf16x8 vf = cat8(trread(ap), trread(ap + 8 * AV_STR));
                    o[dh] = __builtin_amdgcn_mfma_f32_32x32x16_bf16(vf, __builtin_bit_cast(bf16x8, pw[s]), o[dh], 0, 0, 0);
                }
        }
        if (more) {
            const int nb = buf ^ 1;
            *(LAS u32x4*)(L + nb * AK_BYTES + srow * AK_STR + sch * 16) = kreg; *(LAS u32x4*)(L + A_VOFF + nb * AV_BYTES + srow * AV_STR + sch * 16) = vreg;
            if (tid < 64) ((LAS float*)(L + A_BOFF + nb * 256))[tid] = (cref - cval) * LOG2E;
            const float kmax = sqrtf(kpm[bh * 128 + j - 1]) * 1.001f, bmax = (cref - csb[64 * (j - 1) + 63]) * LOG2E;
            const int vote = __all((qn * kmax + bmax - m) < -170.f);
            if (lane == 0) ((LAS int*)(L + A_VOTE + nb * 32))[wid] = vote;
        }
        __syncthreads();
        if (!more) break;
        { const LAS int* vp = (const LAS int*)(L + A_VOTE + (buf ^ 1) * 32); int all = 1;
#pragma unroll
          for (int w = 0; w < 8; ++w) all &= vp[w];
          if (all) break; }
        --j; buf ^= 1;
    }
    l += __shfl_xor(l, 32);
    const float inv = 1.0f / l;
    bf16_t* Op = MIX + (rowbase + t0 + r32) * D + MIX_ATT + h * 64;
#pragma unroll
    for (int dh = 0; dh < 2; ++dh)
#pragma unroll
        for (int g = 0; g < 4; ++g) { u32x2 w; w.x = cvtpk(o[dh][4 * g] * inv, o[dh][4 * g + 1] * inv); w.y = cvtpk(o[dh][4 * g + 2] * inv, o[dh][4 * g + 3] * inv); *(u32x2*)(Op + 32 * dh + 8 * g + 4 * hi) = w; }
    __syncthreads();
}

__device__ __forceinline__ void conv_item(LAS unsigned char* L, const bf16_t* Z, const float* cw, const float* cb, const float* lg, const float* lb, bf16_t* MIX, int item) {
    const int tid = opaque_tid(), lane = tid & 63, wid = tid >> 6; const int b = item >> 8, t0 = (item & 255) * 32; const size_t rowbase = (size_t)b * T;
    LAS float* hs = (LAS float*)L;
    LAS float* ob = (LAS float*)(L + 62 * 1024);
    { u32x4 av[4], gv[4];
#pragma unroll
      for (int k = 0; k < 4; ++k) { const int ci = tid + 512 * k, r = ci >> 5, ch = ci & 31, t = t0 - 30 + r; av[k] = (u32x4){0u, 0u, 0u, 0u}; gv[k] = av[k];
          if (ci < 62 * 32 && t >= 0) { const bf16_t* p = Z + (rowbase + t) * ZP + Z_CV + ch * 8; av[k] = *(const u32x4*)p; gv[k] = *(const u32x4*)(p + 256); } }
#pragma unroll
      for (int k = 0; k < 4; ++k) { const int ci = tid + 512 * k, r = ci >> 5, ch = ci & 31; f32x4 h0, h1;
#pragma unroll
          for (int e = 0; e < 2; ++e) { h0[2 * e] = bflo(av[k][e]) * sigmoidf_(bflo(gv[k][e])); h0[2 * e + 1] = bfhi(av[k][e]) * sigmoidf_(bfhi(gv[k][e])); h1[2 * e] = bflo(av[k][2 + e]) * sigmoidf_(bflo(gv[k][2 + e])); h1[2 * e + 1] = bfhi(av[k][2 + e]) * sigmoidf_(bfhi(gv[k][2 + e])); }
          if (ci < 62 * 32) { *(LAS f32x4*)(hs + r * 256 + ch * 8) = h0; *(LAS f32x4*)(hs + r * 256 + ch * 8 + 4) = h1; } } }
    __syncthreads();
    { const int c = tid & 255, half = tid >> 8; float w[31], hw[46];
#pragma unroll
      for (int jj = 0; jj < 31; ++jj) w[jj] = cw[jj * 256 + c];
      const float bias = cb[c];
#pragma unroll
      for (int i = 0; i < 46; ++i) hw[i] = hs[(16 * half + i) * 256 + c];
#pragma unroll
      for (int tt = 0; tt < 16; ++tt) { float acc = bias;
#pragma unroll
          for (int jj = 0; jj < 31; ++jj) acc += w[jj] * hw[tt + jj];
          ob[(16 * half + tt) * 256 + c] = acc; } }
    __syncthreads();
    { const f32x4 g4 = *(const f32x4*)(lg + 4 * lane), b4 = *(const f32x4*)(lb + 4 * lane);
#pragma unroll
      for (int k = 0; k < 4; ++k) { const int tl = 4 * wid + k; const f32x4 v = *(const LAS f32x4*)(ob + tl * 256 + 4 * lane);
          const float mu = wave_sum((v[0] + v[1]) + (v[2] + v[3])) * (1.f / 256.f); const f32x4 d = v - mu;
          const float var = wave_sum((d[0] * d[0] + d[1] * d[1]) + (d[2] * d[2] + d[3] * d[3])) * (1.f / 256.f); const float rs = rsqrtf(var + 1e-5f);
          const f32x4 y = d * rs * g4 + b4; u32x2 w; w.x = cvtpk(siluf_(y[0]), siluf_(y[1])); w.y = cvtpk(siluf_(y[2]), siluf_(y[3]));
          *(u32x2*)(MIX + (rowbase + t0 + tl) * D + MIX_CNV + 4 * lane) = w; } }
    __syncthreads();
}

__device__ __forceinline__ void hgrn_load_v(LAS unsigned char* vimg, const bf16_t* Z, size_t R0, int hh, int lane) {
#pragma unroll
    for (int it = 0; it < 8; ++it) { const int idx = it * 64 + lane, row = idx >> 3, ch = idx & 7; *(LAS u32x4*)(vimg + row * 128 + ch * 16) = *(const u32x4*)(Z + (R0 + row) * ZP + Z_IH + hh * 64 + ch * 8); }
}
__device__ __forceinline__ void hgrn_elem(float z, float lb, float oml, float& kk, float& g) {
    const float ez = __expf(-fabsf(z)), r = fast_rcp(1.f + ez), sp = r, sn = ez * r;
    const float sg = z >= 0.f ? sp : sn, oms = z >= 0.f ? sn : sp;
    const float f = fmaxf(lb + oml * sg, 1e-30f); kk = oml * oms; g = __logf(f);
}
__device__ __forceinline__ void hgrn_a(LAS unsigned char* Lw, const bf16_t* Z, bf16_t* MIX, const float* ZF, bf16_t* KT, const float* lbl, int layer, float* UT, float* EM, float* EE, int item, int lane) {
    const int c = item & 127, bhh = item >> 7, hh = bhh % 6, b = bhh / 6;
    const size_t R0 = (size_t)b * T + 64 * c; const int col = hh * 64 + lane;
    float lb;
    { float lg[4], mx = -1e30f;
#pragma unroll
      for (int i = 0; i < 4; ++i) { lg[i] = lbl[i * 384 + col]; mx = fmaxf(mx, lg[i]); }
      float se = 0.f, num = 0.f;
#pragma unroll
      for (int i = 0; i < 4; ++i) { const float e = __expf(lg[i] - mx); se += e; if (i >= 1 && i <= layer) num += e; }
      lb = num / se; }
    const float oml = 1.f - lb;
    LAS unsigned char* kimg = Lw; LAS unsigned char* vimg = Lw + 8192;
    hgrn_load_v(vimg, Z, R0, hh, lane);
    float nb = 0.f;
#pragma unroll 1
    for (int bt = 0; bt < 2; ++bt) {
        const int base = 16 - 16 * bt; float zv[16]; unsigned short qv[16];
#pragma unroll
        for (int i = 0; i < 16; ++i) { zv[i] = ZF[(R0 + base + i) * ZFP + ZF_FH + col]; qv[i] = Z[(R0 + base + i) * ZP + Z_QH + col]; }
#pragma unroll
        for (int i = 15; i >= 0; --i) { const int t = base + i; float kk, g; hgrn_elem(zv[i], lb, oml, kk, g);
            const unsigned short qt = f2bf(bf2f(qv[i]) * __expf(-nb)), kt = f2bf(kk * __expf(nb));
            MIX[(R0 + t) * D + MIX_HG + col] = qt; KT[(R0 + t) * 384 + col] = kt; *(LAS unsigned short*)(kimg + t * 128 + lane * 2) = kt; nb += g; }
    }
    float fa = 0.f;
#pragma unroll 1
    for (int bt = 0; bt < 2; ++bt) {
        const int base = 32 + 16 * bt; float zv[16]; unsigned short qv[16];
#pragma unroll
        for (int i = 0; i < 16; ++i) { zv[i] = ZF[(R0 + base + i) * ZFP + ZF_FH + col]; qv[i] = Z[(R0 + base + i) * ZP + Z_QH + col]; }
#pragma unroll
        for (int i = 0; i < 16; ++i) { const int t = base + i; float kk, g; hgrn_elem(zv[i], lb, oml, kk, g); fa += g;
            const unsigned short qt = f2bf(bf2f(qv[i]) * __expf(fa)), kt = f2bf(kk * __expf(-fa));
            MIX[(R0 + t) * D + MIX_HG + col] = qt; KT[(R0 + t) * 384 + col] = kt; *(LAS unsigned short*)(kimg + t * 128 + lane * 2) = kt; }
    }
    EM[(size_t)item * 64 + lane] = __expf(nb); EE[(size_t)item * 64 + lane] = __expf(nb + fa);
    const float usc = __expf(fa);
    asm volatile("s_waitcnt lgkmcnt(0)" ::: "memory");
    const int tq = (lane & 15) >> 2, tp = lane & 3, tg1 = (lane >> 4) & 1, hi = lane >> 5, r32 = lane & 31;
#pragma unroll
    for (int vh = 0; vh < 2; ++vh)
#pragma unroll
        for (int dh = 0; dh < 2; ++dh) {
            f32x16 acc = f32x16{};
#pragma unroll
            for (int st = 0; st < 4; ++st) {
                const LAS unsigned char* ap = vimg + (16 * st + 8 * hi + tq) * 128 + (32 * vh + 16 * tg1 + 4 * tp) * 2;
                const LAS unsigned char* bp = kimg + (16 * st + 8 * hi + tq) * 128 + (32 * dh + 16 * tg1 + 4 * tp) * 2;
                acc = __builtin_amdgcn_mfma_f32_32x32x16_bf16(cat8(trread(ap), trread(ap + 4 * 128)), cat8(trread(bp), trread(bp + 4 * 128)), acc, 0, 0, 0);
            }
            const float sc = __shfl(usc, 32 * dh + r32);
#pragma unroll
            for (int r = 0; r < 16; ++r) UT[(size_t)item * 4096 + (32 * vh + crow(r, hi)) * 64 + 32 * dh + r32] = acc[r] * sc;
        }
    asm volatile("s_waitcnt lgkmcnt(0)" ::: "memory");
}
__device__ __forceinline__ void hgrn_scan(const float* UT, const float* EM, const float* EE, bf16_t* SP, int item) {
    const int bhh = item >> 3, seg = item & 7, e = seg * 512 + opaque_tid(), dk = e & 63;
    float S = 0.f;
#pragma unroll 1
    for (int c0 = 0; c0 < 128; c0 += 16) {
        float u[16], em[16], ee[16];
#pragma unroll
        for (int i = 0; i < 16; ++i) { const size_t it = (size_t)bhh * 128 + c0 + i; u[i] = UT[it * 4096 + e]; em[i] = EM[it * 64 + dk]; ee[i] = EE[it * 64 + dk]; }
#pragma unroll
        for (int i = 0; i < 16; ++i) { const size_t it = (size_t)bhh * 128 + c0 + i; SP[it * 4096 + e] = f2bf(em[i] * S); S = ee[i] * S + u[i]; }
    }
}
__device__ __forceinline__ void hgrn_o(LAS unsigned char* Lw, const bf16_t* Z, const bf16_t* KT, const bf16_t* SP, const float* ng, bf16_t* MIX, int item, int lane) {
    const int c = item & 127, bhh = item >> 7, hh = bhh % 6, b = bhh / 6;
    const size_t R0 = (size_t)b * T + 64 * c;
    const int tq = (lane & 15) >> 2, tp = lane & 3, tg1 = (lane >> 4) & 1, hi = lane >> 5, r32 = lane & 31;
    LAS unsigned char* vimg = Lw;
    hgrn_load_v(vimg, Z, R0, hh, lane);
    asm volatile("s_waitcnt lgkmcnt(0)" ::: "memory");
#pragma unroll 1
    for (int tau = 0; tau < 2; ++tau) {
        bf16x8 qf[4];
        { const bf16_t* qp = MIX + (R0 + 32 * tau + r32) * D + MIX_HG + hh * 64 + 8 * hi;
#pragma unroll
          for (int st = 0; st < 4; ++st) qf[st] = *(const bf16x8*)(qp + 16 * st); }
        f32x16 X[2];
#pragma unroll
        for (int sh = 0; sh < 2; ++sh) { X[sh] = f32x16{}; const bf16_t* kp = KT + (R0 + 32 * sh + r32) * 384 + hh * 64 + 8 * hi;
#pragma unroll
            for (int st = 0; st < 4; ++st) X[sh] = __builtin_amdgcn_mfma_f32_32x32x16_bf16(*(const bf16x8*)(kp + 16 * st), qf[st], X[sh], 0, 0, 0); }
        const int t = 32 * tau + r32;
#pragma unroll
        for (int sh = 0; sh < 2; ++sh)
#pragma unroll
            for (int r = 0; r < 16; ++r) if (32 * sh + crow(r, hi) > t) X[sh][r] = 0.f;
        u32x4 pw[4];
#pragma unroll
        for (int e = 0; e < 4; ++e) { pw[0][e] = cvtpk(X[0][2 * e], X[0][2 * e + 1]); pw[1][e] = cvtpk(X[0][8 + 2 * e], X[0][9 + 2 * e]); pw[2][e] = cvtpk(X[1][2 * e], X[1][2 * e + 1]); pw[3][e] = cvtpk(X[1][8 + 2 * e], X[1][9 + 2 * e]); }
        f32x16 Y[2];
#pragma unroll
        for (int vh = 0; vh < 2; ++vh) { Y[vh] = f32x16{};
#pragma unroll
            for (int st = 0; st < 4; ++st) { const LAS unsigned char* ap = vimg + (16 * st + 4 * hi + tq) * 128 + (32 * vh + 16 * tg1 + 4 * tp) * 2;
                Y[vh] = __builtin_amdgcn_mfma_f32_32x32x16_bf16(cat8(trread(ap), trread(ap + 8 * 128)), __builtin_bit_cast(bf16x8, pw[st]), Y[vh], 0, 0, 0); }
            const bf16_t* sp = SP + ((size_t)item * 64 + 32 * vh + r32) * 64 + 8 * hi;
#pragma unroll
            for (int ds = 0; ds < 4; ++ds) Y[vh] = __builtin_amdgcn_mfma_f32_32x32x16_bf16(*(const bf16x8*)(sp + 16 * ds), qf[ds], Y[vh], 0, 0, 0); }
        float ss = 0.f;
#pragma unroll
        for (int r = 0; r < 16; ++r) ss += Y[0][r] * Y[0][r] + Y[1][r] * Y[1][r];
        ss += __shfl_xor(ss, 32);
        const float rs = rsqrtf(ss * (1.f / 64.f) + 1e-6f);
        const size_t R = R0 + t;
#pragma unroll
        for (int vh = 0; vh < 2; ++vh)
#pragma unroll
            for (int g4 = 0; g4 < 4; ++g4) { const int v0 = 32 * vh + 8 * g4 + 4 * hi;
                const u32x2 gw = *(const u32x2*)(Z + R * ZP + Z_GH + hh * 64 + v0); const f32x4 n4 = *(const f32x4*)(ng + v0);
                const float y0 = Y[vh][4 * g4] * rs * n4[0] * siluf_(bflo(gw.x)), y1 = Y[vh][4 * g4 + 1] * rs * n4[1] * siluf_(bfhi(gw.x));
                const float y2 = Y[vh][4 * g4 + 2] * rs * n4[2] * siluf_(bflo(gw.y)), y3 = Y[vh][4 * g4 + 3] * rs * n4[3] * siluf_(bfhi(gw.y));
                u32x2 w; w.x = cvtpk(y0, y1); w.y = cvtpk(y2, y3); *(u32x2*)(MIX + R * D + MIX_HG + hh * 64 + v0) = w; }
    }
    asm volatile("s_waitcnt lgkmcnt(0)" ::: "memory");
}

#define XB_TMO      128
#define XB_XCNT(j)  (256  + 64 * (j))
#define XB_XSUB(j)  (1280 + 64 * (j))
#define XB_XGEN(j)  (2304 + 64 * (j))
#define XB_TOP      3328
#define XB_TOPGEN   3392
#define XCD_BAR_WORDS 3456
#define XB_SPIN_CAP (1u << 18)

__device__ __forceinline__ unsigned xb_ld(unsigned* p)              { return __hip_atomic_load(p, __ATOMIC_RELAXED, __HIP_MEMORY_SCOPE_AGENT); }
__device__ __forceinline__ unsigned xb_add(unsigned* p, unsigned v) { return __hip_atomic_fetch_add(p, v, __ATOMIC_RELAXED, __HIP_MEMORY_SCOPE_AGENT); }
__device__ __forceinline__ unsigned xb_xcc_id() { return (unsigned)__builtin_amdgcn_s_getreg((3 << 11) | 20) & 0xFu; }
#define XB_SPIN(cond, bar) do { unsigned _sp = 0; while (cond) { __builtin_amdgcn_s_sleep(1); \
    if ((++_sp & 255u) == 0u) { if (xb_ld(&(bar)[XB_TMO])) break; if (_sp > XB_SPIN_CAP) { atomicAdd(&(bar)[XB_TMO], 1u); break; } } } } while (0)

struct XcdBarrier {
    unsigned* bar; unsigned x;
    volatile LAS unsigned* st;
};

__device__ __forceinline__ XcdBarrier xcd_barrier_post(unsigned* bar, volatile LAS unsigned* st) {
    XcdBarrier b; b.bar = bar; b.x = xb_xcc_id(); b.st = st;
    if (threadIdx.x == 0) (void)xb_add(&bar[XB_XCNT(b.x)], 1u);
    return b;
}
__device__ __forceinline__ void xcd_barrier_complete(unsigned* bar, unsigned x, unsigned& nloc, unsigned& nx) {
    const unsigned G = gridDim.x * gridDim.y * gridDim.z;
    unsigned sum, cnt, mine, sp = 0u;
    for (;;) {
        sum = 0u; cnt = 0u; mine = 0u;
#pragma unroll
        for (unsigned j = 0; j < 16; ++j) { const unsigned c = xb_ld(&bar[XB_XCNT(j)]); sum += c; cnt += (c > 0u) ? 1u : 0u; mine = (j == x) ? c : mine; }
        if (sum == G) break;
        __builtin_amdgcn_s_sleep(1);
        if ((++sp & 255u) == 0u) { if (xb_ld(&bar[XB_TMO])) break; if (sp > XB_SPIN_CAP) { atomicAdd(&bar[XB_TMO], 1u); break; } }
    }
    nloc = mine > 0u ? mine : 1u; nx = cnt > 0u ? cnt : 1u;
}

__device__ __forceinline__ void xcd_barrier(const XcdBarrier& b) {
    asm volatile("s_waitcnt vmcnt(0)" ::: "memory");
    __syncthreads();
    if (threadIdx.x == 0) {
        unsigned* bar = b.bar;
        __builtin_amdgcn_s_waitcnt(0);
        unsigned nloc = b.st[0], nx = b.st[1];
        if (nloc == 0u) { xcd_barrier_complete(bar, b.x, nloc, nx); b.st[0] = nloc; b.st[1] = nx; }
        const unsigned old = xb_add(&bar[XB_XSUB(b.x)], 1u);
        const unsigned gen = old / nloc;
        if (old + 1u == (gen + 1u) * nloc) {
            __builtin_amdgcn_fence(__ATOMIC_RELEASE, "agent");
            asm volatile("s_waitcnt vmcnt(0)" ::: "memory");
            const unsigned og = xb_add(&bar[XB_TOP], 1u);
            const unsigned tg = og / nx;
            if (og + 1u == (tg + 1u) * nx) xb_add(&bar[XB_TOPGEN], 1u);
            else XB_SPIN(xb_ld(&bar[XB_TOPGEN]) == tg, bar);
            __builtin_amdgcn_fence(__ATOMIC_ACQUIRE, "agent");
            xb_add(&bar[XB_XGEN(b.x)], 1u);
            asm volatile("s_waitcnt vmcnt(0)" ::: "memory");
        } else {
            XB_SPIN(xb_ld(&bar[XB_XGEN(b.x)]) == gen, bar);
            __builtin_amdgcn_fence(__ATOMIC_ACQUIRE, "agent");
            asm volatile("s_waitcnt vmcnt(0)" ::: "memory");
        }
    }
    __syncthreads();
}

#ifndef REP_P
#define REP_P 1
#endif
#ifndef REP_E
#define REP_E 1
#endif
#ifndef REP_A
#define REP_A 1
#endif
#ifndef REP_C
#define REP_C 1
#endif
#ifndef REP_D
#define REP_D 1
#endif
#ifndef REP_F
#define REP_F 1
#endif
#ifndef REP_B
#define REP_B 1
#endif
#ifndef XSYNC
#define XSYNC 0
#endif
__global__ void __launch_bounds__(512, 2) fwd_megakernel(Args a) {
    extern __shared__ __attribute__((aligned(16))) unsigned char lds_raw[];
    cg::grid_group grid = cg::this_grid();
    LAS unsigned char* lds = (LAS unsigned char*)lds_raw;
    const int G = gridDim.x, bx = blockIdx.x;
    volatile LAS unsigned* MISC = (volatile LAS unsigned*)(lds + LDS_BYTES - 64);
    if (threadIdx.x < 16) MISC[threadIdx.x] = 0u;
    if (bx == 0) for (int u = threadIdx.x; u < 8192; u += 512) ((unsigned*)a.ws)[u] = 0u;
    unsigned char* ws = a.ws;
    bf16_t* win_t = (bf16_t*)(ws + WS_WIN); bf16_t* wout_t = (bf16_t*)(ws + WS_WOUT); bf16_t* wfi_t = (bf16_t*)(ws + WS_WFI); bf16_t* wfo_t = (bf16_t*)(ws + WS_WFO);
    bf16_t* Z = (bf16_t*)(ws + WS_Z); bf16_t* H = Z; float* ZF = (float*)(ws + WS_ZF); bf16_t* SP = (bf16_t*)(ws + WS_ZF);
    bf16_t* XB = (bf16_t*)(ws + WS_XB); float* UT = (float*)(ws + WS_XB); bf16_t* MIX = (bf16_t*)(ws + WS_MIX); bf16_t* KT = (bf16_t*)(ws + WS_KT);
    float* SSQ = (float*)(ws + WS_SSQ); float* CS = (float*)(ws + WS_CS); float* KPM = (float*)(ws + WS_KPM); float* EM = (float*)(ws + WS_EM); float* EE = (float*)(ws + WS_EE);

#ifndef SKIP_P
    for (int rep = 0; rep < REP_P; ++rep) prologue(a, lds, G, bx);
#endif
    grid.sync();
    const XcdBarrier xbar = xcd_barrier_post((unsigned*)a.ws, MISC);
#define GSYNC() xcd_barrier(xbar)
#pragma unroll 1
    for (int l = 0; l < DEPTH; ++l) {
#ifndef SKIP_A
        for (int rep = 0; rep < REP_A; ++rep)
        { pg8::Gemm g{XB, win_t + (size_t)l * NIN * D, M, NIN, D}; pg8::StaticOrder S; S.init(M, NIN, G, bx); EpiIn E{Z, ZF, SSQ};
          pg8::gemm_phase<EpiIn, pg8::StaticOrder, true, true>(lds, g, S, E); }
#endif
        GSYNC();
#ifndef SKIP_B
        for (int rep = 0; rep < REP_B; ++rep) {
        for (int it = bx; it < 24 + 1024; it += G) {
            if (it < 24) attn_prep(lds, Z, ZF, a.fgate_b + l * 6, CS, KPM, it);
            else conv_item(lds, Z, a.conv_w + (size_t)l * 31 * 256, a.conv_b + l * 256, a.conv_ln_g + l * 256, a.conv_ln_b + l * 256, MIX, it - 24);
        }
        __syncthreads();
        { const int tid = opaque_tid(), lane = tid & 63, wid = __builtin_amdgcn_readfirstlane(tid >> 6);
          for (int it = bx * 8 + wid; it < NHITEM; it += G * 8) hgrn_a(lds + wid * 16384, Z, MIX, ZF, KT, a.lb_logits, l, UT, EM, EE, it, lane); }
        __syncthreads(); }
#endif
        GSYNC();
#ifndef SKIP_C
        for (int rep = 0; rep < REP_C; ++rep) {
        for (int it = bx; it < 192; it += G) hgrn_scan(UT, EM, EE, SP, it);
        for (;;) {
            if (threadIdx.x == 0) MISC[4] = atomicAdd((unsigned*)a.ws + 4096 + 64 * (l * REP_C + rep), 1u);
            __syncthreads();
            const int pos = (int)MISC[4];
            if (pos >= 768) break;
            attn_unit(lds, Z, CS, KPM, MIX, pos % 24, 31 - pos / 24);
        }
        __syncthreads();
        }
        for (int xs = 0; xs < XSYNC; ++xs) GSYNC();
#endif
        GSYNC();
#ifndef SKIP_D
        for (int rep = 0; rep < REP_D; ++rep)
        { const int tid = opaque_tid(), lane = tid & 63, wid = __builtin_amdgcn_readfirstlane(tid >> 6);
          for (int it = bx * 8 + wid; it < NHITEM; it += G * 8) hgrn_o(lds + wid * 16384, Z, KT, SP, a.hgrn_norm_g + l * 64, MIX, it, lane); }
#endif
        GSYNC();
#ifndef SKIP_E
        for (int rep = 0; rep < ((l == 0) ? REP_E : 1); ++rep)
        { pg8::Gemm g{MIX, wout_t + (size_t)l * D * D, M, D, D}; pg8::StaticOrder S; S.init(M, D, G, bx); EpiRes E{l == 0 ? a.x : a.out, a.out, XB, SSQ};
          pg8::gemm_phase<EpiRes, pg8::StaticOrder, true, true>(lds, g, S, E); }
#endif
        GSYNC();
#ifndef SKIP_F
        for (int rep = 0; rep < REP_F; ++rep)
        { pg8::Gemm g{XB, wfi_t + (size_t)l * NFF * D, M, NFF, D}; pg8::StaticOrder S; S.init(M, NFF, G, bx); EpiGlu E{H, SSQ};
          pg8::gemm_phase<EpiGlu, pg8::StaticOrder, true, true>(lds, g, S, E); }
#endif
        GSYNC();
#ifndef SKIP_G
        { pg8::Gemm g{H, wfo_t + (size_t)l * D * DFF, M, D, DFF}; pg8::StaticOrder S; S.init(M, D, G, bx); EpiRes E{a.out, a.out, XB, SSQ};
          pg8::gemm_phase<EpiRes, pg8::StaticOrder, true, true>(lds, g, S, E); }
#endif
        GSYNC();
    }
#ifndef SKIP_N
    final_norm(a, G, bx);
#endif
}

extern "C" void kernel_launch(void* const* d_in, const int* in_sizes, int n_in, void* d_out, int out_size, void* d_ws, size_t ws_size, hipStream_t stream) {
    static int grid = 0;
    if (grid == 0) {
        if (n_in != 15 || out_size != M * D || ws_size < WS_END) { fprintf(stderr, "kernel_launch: unexpected problem (n_in %d out %d ws %zu)\n", n_in, out_size, ws_size); grid = -1; return; }
        int dev = 0, cus = 0, per = 0;
        hipGetDevice(&dev); hipDeviceGetAttribute(&cus, hipDeviceAttributeMultiprocessorCount, dev);
        hipFuncSetAttribute((const void*)fwd_megakernel, hipFuncAttributeMaxDynamicSharedMemorySize, LDS_BYTES);
        if (hipOccupancyMaxActiveBlocksPerMultiprocessor(&per, (const void*)fwd_megakernel, 512, LDS_BYTES) != hipSuccess || per < 1) { fprintf(stderr, "kernel_launch: occupancy query gave %d\n", per); per = 1; }
        (void)hipGetLastError();
        grid = cus * per;
        fprintf(stderr, "kernel_launch: grid %d (cus %d x %d), ws %zu\n", grid, cus, per, ws_size);
    }
    if (grid < 0) return;
    Args a{};
    a.x = (const float*)d_in[0]; a.norm_mix_g = (const float*)d_in[1]; a.w_in = (const float*)d_in[2]; a.fgate_b = (const float*)d_in[3]; a.conv_w = (const float*)d_in[4];
    a.conv_b = (const float*)d_in[5]; a.conv_ln_g = (const float*)d_in[6]; a.conv_ln_b = (const float*)d_in[7]; a.lb_logits = (const float*)d_in[8]; a.hgrn_norm_g = (const float*)d_in[9];
    a.w_out = (const float*)d_in[10]; a.norm_ffn_g = (const float*)d_in[11]; a.w_ffn_in = (const float*)d_in[12]; a.w_ffn_out = (const float*)d_in[13]; a.norm_final_g = (const float*)d_in[14];
    a.out = (float*)d_out; a.ws = (unsigned char*)d_ws;
    void* args[] = {&a};
    hipError_t e = hipLaunchCooperativeKernel((const void*)fwd_megakernel, dim3(grid), dim3(512), args, LDS_BYTES, stream);
    if (e != hipSuccess) fprintf(stderr, "kernel_launch: cooperative launch failed: %s (grid %d)\n", hipGetErrorString(e), grid);
}
```

```cpp
#include <hip/hip_runtime.h>
#include <hip/hip_cooperative_groups.h>
#include <cstdio>
#include <cstdint>
namespace cg = cooperative_groups;
__device__ __forceinline__ int opaque_tid() { int t = threadIdx.x; asm volatile("" : "+v"(t)); return t; }
namespace pg8 {
#define PG8_LAS __attribute__((address_space(3)))
typedef unsigned short bf16_t;
typedef short bf16x8 __attribute__((ext_vector_type(8)));
typedef float f32x4 __attribute__((ext_vector_type(4)));
typedef unsigned u32x4 __attribute__((ext_vector_type(4)));
constexpr int BM = 256, BK = 64, HALF = 128, HTB = HALF * BK * 2  , STAGE_BYTES = 8 * HTB, NXCD = 8, WGM = 8;

__host__ __device__ __forceinline__ int lds_byte(int r, int c) { const int st = (r >> 4) * 2 + (c >> 5), rr = r & 15, cc = c & 31, ob = rr * 64 + cc * 2; return st * 1024 + (ob ^ (((ob >> 9) & 1) << 5)); }
__host__ __device__ __forceinline__ void stage_rc(int b, int& R, int& C) { const int st = b / 1024, sb = b % 1024, swz = sb ^ (((sb >> 9) & 1) << 5); R = (st >> 1) * 16 + swz / 64; C = (st & 1) * 32 + (swz % 64) / 2; }
__host__ __device__ __forceinline__ int perm32(int rho) { const int n = rho >> 4, i = rho & 15; return 8 * (i >> 2) + 4 * n + (i & 3); }

struct Unit { int pm, pn; };
struct Gemm { const bf16_t* A; const bf16_t* Bt; int M, N, K; };

struct StaticOrder {
    int nM, nN, nwg, G, c;
    __host__ __device__ void init(int M, int N, int G_, int c_) { nM = M / BM; nN = N / BM; nwg = nM * nN; G = G_; c = c_; }
    __host__ __device__ bool next(int i, Unit& u) const {
        const long L = (long)i * G + c; if (L >= nwg) return false;
        int wgid = (int)L; { const int q = nwg / NXCD, r = nwg % NXCD, xcd = wgid % NXCD, off = wgid / NXCD; wgid = (xcd < r ? xcd * (q + 1) : r * (q + 1) + (xcd - r) * q) + off; }
        const int nig = WGM * nN, gid = wgid / nig, fm = gid * WGM, gsz = (nM - fm) < WGM ? (nM - fm) : WGM;
        u.pm = fm + ((wgid % nig) % gsz); u.pn = (wgid % nig) / gsz; return true;
    }
    __device__ __forceinline__ void a_ready(const Unit&) const {}
    __device__ __forceinline__ void done(const Unit&) const {}
};

__device__ __forceinline__ unsigned cvt_pk_bf16(float lo, float hi) { unsigned r; asm volatile("v_cvt_pk_bf16_f32 %0, %1, %2" : "=v"(r) : "v"(lo), "v"(hi)); return r; }
typedef float f32x2 __attribute__((ext_vector_type(2)));
template <class Epi, class Sched, bool ALIGN_EPI = false, bool SP2 = false>
__device__ __forceinline__ void gemm_phase(PG8_LAS unsigned char* lds, const Gemm g, const Sched& S, const Epi& E) {
    const int tid = opaque_tid(), wid = __builtin_amdgcn_readfirstlane(tid >> 6), lane = tid & 63, wr = wid >> 2, wc = wid & 3, fr = lane & 15, fq = lane >> 4;
    const int K = g.K, nt = K / BK;
    unsigned voffA[2], voffB[2];
#pragma unroll
    for (int i = 0; i < 2; ++i) { int R, C; stage_rc(tid * 16 + i * 8192, R, C); const int Rb = Epi::PERM ? ((R & ~31) + perm32(R & 31)) : R;
        voffA[i] = (unsigned)(R * K + C) * 2u; voffB[i] = (unsigned)(Rb * K + C) * 2u; }
    const size_t kstep = (size_t)(BK * 2);
    const size_t hstep = (size_t)HALF * K * 2;
    const size_t tstep = 2 * hstep;
    const unsigned ldsw = (unsigned)wid * 1024u;
    const int aoff = lds_byte(wr * 64 + fr, fq * 8), boff = lds_byte(wc * 32 + fr, fq * 8);
#define PG8_SA(b, h) (((b) * 2 + (h)) * HTB)
#define PG8_SB(b, h) ((4 + (b) * 2 + (h)) * HTB)
#define PG8_STAGE(bufoff, gbase, voff) do { _Pragma("unroll") for (int _i = 0; _i < 2; ++_i) \
        __builtin_amdgcn_global_load_lds((const unsigned*)((const char*)(gbase) + (voff)[_i]), (PG8_LAS unsigned*)(lds + (bufoff) + ldsw + _i * 8192), 16, 0, 0); } while (0)
#define PG8_LDA(dst, b, h) do { _Pragma("unroll") for (int m = 0; m < 4; ++m) _Pragma("unroll") for (int k = 0; k < 2; ++k) dst[m][k] = *(const PG8_LAS bf16x8*)(lds + PG8_SA(b, h) + aoff + m * 2048 + k * 1024); } while (0)
#define PG8_LDB(dst, b, h) do { _Pragma("unroll") for (int n = 0; n < 2; ++n) _Pragma("unroll") for (int k = 0; k < 2; ++k) dst[n][k] = *(const PG8_LAS bf16x8*)(lds + PG8_SB(b, h) + boff + n * 2048 + k * 1024); } while (0)
#define PG8_MMA(ai, bj, At, Bt) do { __builtin_amdgcn_s_setprio(1); _Pragma("unroll") for (int m = 0; m < 4; ++m) _Pragma("unroll") for (int n = 0; n < 2; ++n) _Pragma("unroll") for (int k = 0; k < 2; ++k) \
        acc[ai][bj][m][n] = __builtin_amdgcn_mfma_f32_16x16x32_bf16(Bt[n][k], At[m][k], acc[ai][bj][m][n], 0, 0, 0); __builtin_amdgcn_s_setprio(0); } while (0)
#define PG8_WAIT_V(n) asm volatile("s_waitcnt vmcnt(" #n ")" ::: "memory")
#define PG8_WAIT_L(n) asm volatile("s_waitcnt lgkmcnt(" #n ")" ::: "memory")
#define PG8_BAR __builtin_amdgcn_s_barrier()
#define PG8_SCHED __builtin_amdgcn_sched_barrier(0)
    Unit cur, nxt; int ui = 0;
    if (!S.next(0, cur)) return;
    f32x4 acc[2][2][4][2];
#pragma unroll
    for (int a = 0; a < 2; ++a)
#pragma unroll
        for (int b = 0; b < 2; ++b)
#pragma unroll
            for (int m = 0; m < 4; ++m)
#pragma unroll
                for (int n = 0; n < 2; ++n) acc[a][b][m][n] = (f32x4){0.f, 0.f, 0.f, 0.f};
    bf16x8 At[4][2], B0[2][2], B1[2][2];
    const char* cA = (const char*)g.A + (size_t)cur.pm * tstep; const char* cB = (const char*)g.Bt + (size_t)cur.pn * tstep;
    S.a_ready(cur);
    if constexpr (SP2) {
        PG8_STAGE(PG8_SB(0, 0), cB, voffB); PG8_STAGE(PG8_SB(0, 1), cB + hstep, voffB); PG8_STAGE(PG8_SA(0, 0), cA, voffA); PG8_STAGE(PG8_SA(0, 1), cA + hstep, voffA);
        if (wr == 1) PG8_BAR;
        PG8_WAIT_V(2); PG8_BAR;
        PG8_STAGE(PG8_SB(1, 0), cB + kstep, voffB); PG8_STAGE(PG8_SA(1, 0), cA + kstep, voffA); PG8_STAGE(PG8_SB(1, 1), cB + hstep + kstep, voffB);
        PG8_WAIT_V(6); PG8_BAR;
    } else {
        PG8_STAGE(PG8_SB(0, 0), cB, voffB); PG8_STAGE(PG8_SA(0, 0), cA, voffA); PG8_STAGE(PG8_SB(0, 1), cB + hstep, voffB); PG8_STAGE(PG8_SA(0, 1), cA + hstep, voffA);
        if (wr == 1) PG8_BAR;
        PG8_WAIT_V(4); PG8_BAR;
        PG8_STAGE(PG8_SB(1, 0), cB + kstep, voffB); PG8_STAGE(PG8_SA(1, 0), cA + kstep, voffA); PG8_STAGE(PG8_SB(1, 1), cB + hstep + kstep, voffB);
        PG8_WAIT_V(6); PG8_BAR;
    }
    for (;;) {
        const bool has_next = S.next(ui + 1, nxt);
        const char* nA = has_next ? (const char*)g.A + (size_t)nxt.pm * tstep : cA; const char* nB = has_next ? (const char*)g.Bt + (size_t)nxt.pn * tstep : cB;
        for (int t = 0; t < nt; t += 2) {
            const bool last = (t == nt - 2);
            const char* a1 = cA + (size_t)(t + 1) * kstep;
            const char* a2 = last ? nA : cA + (size_t)(t + 2) * kstep; const char* b2 = last ? nB : cB + (size_t)(t + 2) * kstep;
            const char* a3 = a2 + kstep; const char* b3 = b2 + kstep;
            if (last && has_next) S.a_ready(nxt);
            if constexpr (SP2) {
            PG8_LDB(B0, 0, 0); PG8_LDB(B1, 0, 1); PG8_SCHED; PG8_LDA(At, 0, 0); PG8_STAGE(PG8_SA(1, 1), a1 + hstep, voffA);
            PG8_WAIT_V(8); PG8_WAIT_L(0); PG8_BAR; PG8_MMA(0, 0, At, B0); PG8_MMA(0, 1, At, B1); PG8_BAR; PG8_SCHED;
            PG8_LDA(At, 0, 1); PG8_STAGE(PG8_SB(0, 0), b2, voffB); PG8_STAGE(PG8_SB(0, 1), b2 + hstep, voffB); PG8_STAGE(PG8_SA(0, 0), a2, voffA);
            PG8_WAIT_V(8); PG8_WAIT_L(0); PG8_BAR; PG8_MMA(1, 0, At, B0); PG8_MMA(1, 1, At, B1); PG8_BAR; PG8_SCHED;
            PG8_LDB(B0, 1, 0); PG8_LDB(B1, 1, 1); PG8_SCHED; PG8_LDA(At, 1, 0); PG8_STAGE(PG8_SA(0, 1), a2 + hstep, voffA);
            PG8_WAIT_V(8); PG8_WAIT_L(0); PG8_BAR; PG8_MMA(0, 0, At, B0); PG8_MMA(0, 1, At, B1); PG8_BAR; PG8_SCHED;
            PG8_LDA(At, 1, 1); PG8_STAGE(PG8_SB(1, 0), b3, voffB); PG8_STAGE(PG8_SB(1, 1), b3 + hstep, voffB); PG8_STAGE(PG8_SA(1, 0), a3, voffA);
            PG8_WAIT_V(8); PG8_WAIT_L(0); PG8_BAR; PG8_MMA(1, 0, At, B0); PG8_MMA(1, 1, At, B1); PG8_BAR; PG8_SCHED;
            } else {
            PG8_LDB(B0, 0, 0); PG8_SCHED; PG8_LDA(At, 0, 0); PG8_STAGE(PG8_SA(1, 1), a1 + hstep, voffA);
            PG8_WAIT_L(8); PG8_BAR; PG8_WAIT_L(0); PG8_MMA(0, 0, At, B0); PG8_BAR; PG8_SCHED;
            PG8_LDB(B1, 0, 1); PG8_STAGE(PG8_SB(0, 0), b2, voffB);
            PG8_BAR; PG8_WAIT_L(0); PG8_MMA(0, 1, At, B1); PG8_BAR;
            PG8_LDA(At, 0, 1); PG8_STAGE(PG8_SA(0, 0), a2, voffA);
            PG8_BAR; PG8_WAIT_L(0); PG8_MMA(1, 0, At, B0); PG8_BAR; PG8_SCHED;
            PG8_STAGE(PG8_SB(0, 1), b2 + hstep, voffB);
            PG8_WAIT_V(6); PG8_BAR; PG8_MMA(1, 1, At, B1); PG8_BAR;
            PG8_LDB(B0, 1, 0); PG8_SCHED; PG8_LDA(At, 1, 0); PG8_STAGE(PG8_SA(0, 1), a2 + hstep, voffA);
            PG8_WAIT_L(8); PG8_BAR; PG8_WAIT_L(0); PG8_MMA(0, 0, At, B0); PG8_BAR; PG8_SCHED;
            PG8_LDB(B1, 1, 1); PG8_STAGE(PG8_SB(1, 0), b3, voffB);
            PG8_BAR; PG8_WAIT_L(0); PG8_MMA(0, 1, At, B1); PG8_BAR;
            PG8_LDA(At, 1, 1); PG8_STAGE(PG8_SA(1, 0), a3, voffA);
            PG8_BAR; PG8_WAIT_L(0); PG8_MMA(1, 0, At, B0); PG8_BAR; PG8_SCHED;
            PG8_STAGE(PG8_SB(1, 1), b3 + hstep, voffB);
            PG8_WAIT_V(6); PG8_BAR; PG8_MMA(1, 1, At, B1); PG8_BAR;
            }
        }
        if constexpr (ALIGN_EPI) { if (wr == 0) PG8_BAR; }
        if constexpr (!Epi::AFTER_DRAIN) { E(acc, cur, wr, wc, fr, fq); S.done(cur); }
        if (!has_next) break;
#pragma unroll
        for (int a = 0; a < 2; ++a)
#pragma unroll
            for (int b = 0; b < 2; ++b)
#pragma unroll
                for (int m = 0; m < 4; ++m)
#pragma unroll
                    for (int n = 0; n < 2; ++n) acc[a][b][m][n] = (f32x4){0.f, 0.f, 0.f, 0.f};
        cur = nxt; cA = nA; cB = nB; ++ui;
        if constexpr (ALIGN_EPI) { if (wr == 1) PG8_BAR; }
    }
    PG8_WAIT_V(0);
    if constexpr (!ALIGN_EPI) { if (wr == 0) PG8_BAR; }
    PG8_BAR;
    if constexpr (Epi::AFTER_DRAIN) { E.fused(acc, cur, wr, wc, fr, fq, lds, wid, lane); S.done(cur); }
#undef PG8_SA
#undef PG8_SB
#undef PG8_STAGE
#undef PG8_LDA
#undef PG8_LDB
#undef PG8_MMA
#undef PG8_WAIT_V
#undef PG8_WAIT_L
#undef PG8_BAR
#undef PG8_SCHED
}
}
#define LAS __attribute__((address_space(3)))
typedef unsigned short bf16_t;
typedef short bf16x8 __attribute__((ext_vector_type(8)));
typedef short s16x4 __attribute__((ext_vector_type(4)));
typedef float f32x4 __attribute__((ext_vector_type(4)));
typedef float f32x16 __attribute__((ext_vector_type(16)));
typedef unsigned u32x4 __attribute__((ext_vector_type(4)));
typedef unsigned u32x2 __attribute__((ext_vector_type(2)));
typedef float f32x2_t __attribute__((ext_vector_type(2)));
typedef __bf16 bf16x2_t __attribute__((ext_vector_type(2)));

constexpr int NBATCH = 4, T = 8192, D = 1024, DEPTH = 4, M = NBATCH * T;
constexpr int DIN = 3206, NIN = 3328, DFF = 2816, NFF = 5632;
constexpr int ZP = 2816, ZFP = 512;
constexpr int Z_QA = 0, Z_KA = 384, Z_VA = 768, Z_CV = 1152, Z_QH = 1664, Z_IH = 2048, Z_GH = 2432;
constexpr int ZF_FH = 0, ZF_FA = 384;
constexpr int MIX_ATT = 0, MIX_CNV = 384, MIX_HG = 640;
constexpr float LOG2E = 1.4426950408889634f;
constexpr float QSCALE = 0.125f * LOG2E;
constexpr int NHITEM = NBATCH * 6 * 128;
constexpr size_t MiB = 1u << 20;
constexpr size_t WS_WIN = 1 * MiB, WS_WOUT = 27 * MiB, WS_WFI = 35 * MiB, WS_WFO = 79 * MiB, WS_Z = 101 * MiB, WS_ZF = 277 * MiB, WS_XB = 341 * MiB,
                 WS_MIX = 405 * MiB, WS_KT = 469 * MiB, WS_SSQ = 493 * MiB, WS_CS = 495 * MiB, WS_KPM = 496 * MiB, WS_EM = 497 * MiB, WS_EE = 498 * MiB, WS_END = 499 * MiB;
constexpr int LDS_BYTES = 135168;

struct Args {
    const float *x, *norm_mix_g, *w_in, *fgate_b, *conv_w, *conv_b, *conv_ln_g, *conv_ln_b, *lb_logits, *hgrn_norm_g, *w_out, *norm_ffn_g, *w_ffn_in, *w_ffn_out, *norm_final_g;
    float* out; unsigned char* ws;
};

__device__ __forceinline__ unsigned cvtpk(float lo, float hi) { f32x2_t v = {lo, hi}; bf16x2_t b = __builtin_convertvector(v, bf16x2_t); return __builtin_bit_cast(unsigned, b); }
__device__ __forceinline__ float bf2f(unsigned short u) { return __uint_as_float((unsigned)u << 16); }
__device__ __forceinline__ float bflo(unsigned u) { return __uint_as_float(u << 16); }
__device__ __forceinline__ float bfhi(unsigned u) { return __uint_as_float(u & 0xffff0000u); }
__device__ __forceinline__ unsigned short f2bf(float f) { return (unsigned short)(cvtpk(f, 0.f) & 0xffffu); }
__device__ __forceinline__ float fast_rcp(float x) { return __builtin_amdgcn_rcpf(x); }
__device__ __forceinline__ float sigmoidf_(float x) { return fast_rcp(1.f + __expf(-x)); }
__device__ __forceinline__ float siluf_(float x) { return x * fast_rcp(1.f + __expf(-x)); }
__device__ __forceinline__ int crow(int r, int hi) { return (r & 3) + 8 * (r >> 2) + 4 * hi; }
__device__ __forceinline__ s16x4 trread(const LAS unsigned char* p) { typedef short v4i16_t __attribute__((ext_vector_type(4))); return __builtin_bit_cast(s16x4, __builtin_amdgcn_ds_read_tr16_b64_v4i16((LAS v4i16_t*)p)); }
__device__ __forceinline__ bf16x8 cat8(s16x4 lo, s16x4 hi) { return (bf16x8){lo[0], lo[1], lo[2], lo[3], hi[0], hi[1], hi[2], hi[3]}; }
__device__ __forceinline__ float wave_sum(float v) {
#pragma unroll
    for (int o = 1; o < 64; o <<= 1) v += __shfl_xor(v, o);
    return v;
}

__device__ __forceinline__ float row_rstd(const float* ssq, int row, int fq) {
    const f32x4 p = *(const f32x4*)(ssq + (size_t)row * 16 + 4 * fq);
    float s = (p[0] + p[1]) + (p[2] + p[3]); s += __shfl_xor(s, 16); s += __shfl_xor(s, 32);
    return rsqrtf(s * (1.0f / D) + 1e-6f);
}
struct EpiIn {
    static constexpr bool PERM = true, AFTER_DRAIN = false;
    bf16_t* Z; float* ZF; const float* ssq;
    __device__ __forceinline__ void operator()(const pg8::f32x4 (&acc)[2][2][4][2], const pg8::Unit& u, int wr, int wc, int fr, int fq) const {
        const int row0 = u.pm * 256 + wr * 64 + fr, col0 = u.pn * 256 + wc * 32 + 8 * fq;
        float rsv[2][4];
#pragma unroll
        for (int ai = 0; ai < 2; ++ai)
#pragma unroll
            for (int m = 0; m < 4; ++m) rsv[ai][m] = row_rstd(ssq, row0 + ai * 128 + m * 16, fq);
        asm volatile("" ::: "memory");
#pragma unroll
        for (int ai = 0; ai < 2; ++ai)
#pragma unroll
            for (int m = 0; m < 4; ++m) {
                const int row = row0 + ai * 128 + m * 16; const float rs = rsv[ai][m];
#pragma unroll
                for (int bj = 0; bj < 2; ++bj) {
                    const f32x4 v0 = acc[ai][bj][m][0] * rs, v1 = acc[ai][bj][m][1] * rs; const int c = col0 + bj * 128;
                    if (u.pn < 11) { u32x4 w; w.x = cvtpk(v0[0], v0[1]); w.y = cvtpk(v0[2], v0[3]); w.z = cvtpk(v1[0], v1[1]); w.w = cvtpk(v1[2], v1[3]); *(u32x4*)(Z + (size_t)row * ZP + c) = w; }
                    else { float* p = ZF + (size_t)row * ZFP + (c - 2816); *(f32x4*)p = v0; *(f32x4*)(p + 4) = v1; }
                }
            }
    }
};
template <bool LAST>
struct EpiRes {
    static constexpr bool PERM = true, AFTER_DRAIN = false;
    float* out; bf16_t* xb; float* ssq;
    __device__ __forceinline__ void operator()(const pg8::f32x4 (&acc)[2][2][4][2], const pg8::Unit& u, int wr, int wc, int fr, int fq) const {
        const int row0 = u.pm * 256 + wr * 64 + fr, col0 = u.pn * 256 + wc * 32 + 8 * fq;
#pragma unroll
        for (int ai = 0; ai < 2; ++ai) {
        u32x4 bv[4][2];
#pragma unroll
            for (int m = 0; m < 4; ++m)
#pragma unroll
                for (int bj = 0; bj < 2; ++bj) bv[m][bj] = *(const u32x4*)(xb + (size_t)(row0 + ai * 128 + m * 16) * D + col0 + bj * 128);
        asm volatile("" ::: "memory");
#pragma unroll
            for (int m = 0; m < 4; ++m) {
                const int row = row0 + ai * 128 + m * 16; float q = 0.f;
#pragma unroll
                for (int bj = 0; bj < 2; ++bj) {
                    const size_t off = (size_t)row * D + col0 + bj * 128; const u32x4 b = bv[m][bj];
                    const f32x4 v0 = acc[ai][bj][m][0] + (f32x4){bflo(b.x), bfhi(b.x), bflo(b.y), bfhi(b.y)}, v1 = acc[ai][bj][m][1] + (f32x4){bflo(b.z), bfhi(b.z), bflo(b.w), bfhi(b.w)};
                    if (LAST) { *(f32x4*)(out + off) = v0; *(f32x4*)(out + off + 4) = v1; }
                    else { u32x4 w; w.x = cvtpk(v0[0], v0[1]); w.y = cvtpk(v0[2], v0[3]); w.z = cvtpk(v1[0], v1[1]); w.w = cvtpk(v1[2], v1[3]); *(u32x4*)(xb + off) = w; }
                    q += (v0[0] * v0[0] + v0[1] * v0[1]) + (v0[2] * v0[2] + v0[3] * v0[3]) + (v1[0] * v1[0] + v1[1] * v1[1]) + (v1[2] * v1[2] + v1[3] * v1[3]);
                }
                q += __shfl_xor(q, 16); q += __shfl_xor(q, 32);
                if (fq == 0) ssq[(size_t)row * 16 + u.pn * 4 + wc] = q;
            }
        asm volatile("" ::: "memory");
        }
    }
};
struct EpiGlu {
    static constexpr bool PERM = true, AFTER_DRAIN = false;
    bf16_t* H; const float* ssq;
    __device__ __forceinline__ void operator()(const pg8::f32x4 (&acc)[2][2][4][2], const pg8::Unit& u, int wr, int wc, int fr, int fq) const {
        const int row0 = u.pm * 256 + wr * 64 + fr, col0 = u.pn * 128 + wc * 32 + 8 * fq;
        float rsv[2][4];
#pragma unroll
        for (int ai = 0; ai < 2; ++ai)
#pragma unroll
            for (int m = 0; m < 4; ++m) rsv[ai][m] = row_rstd(ssq, row0 + ai * 128 + m * 16, fq);
        asm volatile("" ::: "memory");
#pragma unroll
        for (int ai = 0; ai < 2; ++ai)
#pragma unroll
            for (int m = 0; m < 4; ++m) {
                const int row = row0 + ai * 128 + m * 16; const float rs = rsv[ai][m];
                float hv[8];
#pragma unroll
                for (int n = 0; n < 2; ++n)
#pragma unroll
                    for (int e = 0; e < 4; ++e) { const float g = acc[ai][0][m][n][e] * rs, up = acc[ai][1][m][n][e] * rs; hv[n * 4 + e] = siluf_(g) * up; }
                u32x4 w; w.x = cvtpk(hv[0], hv[1]); w.y = cvtpk(hv[2], hv[3]); w.z = cvtpk(hv[4], hv[5]); w.w = cvtpk(hv[6], hv[7]);
                *(u32x4*)(H + (size_t)row * DFF + col0) = w;
            }
    }
};
__device__ __forceinline__ int map_win(int n) {
    if (n < 1152) return n;
    if (n < 1158) return 3200 + (n - 1152);
    if (n < 1670) return Z_CV + (n - 1158);
    if (n < 2054) return Z_QH + (n - 1670);
    if (n < 2438) return 2816 + (n - 2054);
    if (n < 2822) return Z_IH + (n - 2438);
    return Z_GH + (n - 2822);
}
template <int MODE>
__device__ __forceinline__ void transpose_item(const float* W, int K, int N, bf16_t* WT, const float* gs, LAS float* scr, int item, int lane) {
    const int nblk = (N + 31) / 32, kb = item / nblk, nb = item % nblk, k0 = 64 * kb, n0 = 32 * nb;
    const int nn = n0 + (lane & 31);
    float tv[32];
#pragma unroll
    for (int i = 0; i < 32; ++i) { const int kk = 2 * i + (lane >> 5); tv[i] = (nn < N) ? W[(size_t)(k0 + kk) * N + nn] : 0.f; }
    const int c = lane & 7;
    f32x4 g0 = {1.f, 1.f, 1.f, 1.f}, g1 = g0;
    if (gs) { g0 = *(const f32x4*)(gs + k0 + 8 * c); g1 = *(const f32x4*)(gs + k0 + 8 * c + 4); }
#pragma unroll
    for (int i = 0; i < 32; ++i) scr[(2 * i + (lane >> 5)) * 33 + (lane & 31)] = tv[i];
    asm volatile("s_waitcnt lgkmcnt(0)" ::: "memory");
#pragma unroll
    for (int j = 0; j < 4; ++j) {
        const int nl = (lane >> 3) + 8 * j, n = n0 + nl; const LAS float* s = scr + (8 * c) * 33 + nl;
        if (n < N) {
            int row; float sc = 1.f;
            if (MODE == 0) { row = map_win(n); if (n < 384) sc = QSCALE; }
            else if (MODE == 2) { row = (n < DFF) ? ((n >> 7) * 256 + (n & 127)) : ((((n - DFF) >> 7) * 256) + 128 + ((n - DFF) & 127)); }
            else row = n;
            u32x4 o; o.x = cvtpk(s[0 * 33] * (sc * g0[0]), s[1 * 33] * (sc * g0[1])); o.y = cvtpk(s[2 * 33] * (sc * g0[2]), s[3 * 33] * (sc * g0[3]));
            o.z = cvtpk(s[4 * 33] * (sc * g1[0]), s[5 * 33] * (sc * g1[1])); o.w = cvtpk(s[6 * 33] * (sc * g1[2]), s[7 * 33] * (sc * g1[3]));
            *(u32x4*)(WT + (size_t)row * K + k0 + 8 * c) = o;
        }
    }
    asm volatile("s_waitcnt lgkmcnt(0)" ::: "memory");
}
__device__ __forceinline__ void prologue(const Args& a, LAS unsigned char* lds, int G, int bx) {
    const int tid = opaque_tid(), lane = tid & 63, wid = __builtin_amdgcn_readfirstlane(tid >> 6), gw = bx * 8 + wid, NGW = G * 8;
    LAS float* scr = (LAS float*)(lds + wid * 16384);
    constexpr int I_IN = 16 * 101, I_OUT = 16 * 32, I_FI = 16 * 176, I_FO = 44 * 32, I_L = I_IN + I_OUT + I_FI + I_FO;
    for (int it = gw; it < DEPTH * I_L; it += NGW) {
        const int l = it / I_L; int r = it % I_L;
        if (r < I_IN) { transpose_item<0>(a.w_in + (size_t)l * D * DIN, D, DIN, (bf16_t*)(a.ws + WS_WIN) + (size_t)l * NIN * D, a.norm_mix_g + l * D, scr, r, lane); continue; } r -= I_IN;
        if (r < I_OUT) { transpose_item<1>(a.w_out + (size_t)l * D * D, D, D, (bf16_t*)(a.ws + WS_WOUT) + (size_t)l * D * D, nullptr, scr, r, lane); continue; } r -= I_OUT;
        if (r < I_FI) { transpose_item<2>(a.w_ffn_in + (size_t)l * D * NFF, D, NFF, (bf16_t*)(a.ws + WS_WFI) + (size_t)l * NFF * D, a.norm_ffn_g + l * D, scr, r, lane); continue; } r -= I_FI;
        transpose_item<1>(a.w_ffn_out + (size_t)l * DFF * D, DFF, D, (bf16_t*)(a.ws + WS_WFO) + (size_t)l * D * DFF, nullptr, scr, r, lane);
    }
    bf16_t* xb = (bf16_t*)(a.ws + WS_XB); float* ssq = (float*)(a.ws + WS_SSQ);
    for (int m = gw; m < M; m += NGW) {
        const f32x4* xr = (const f32x4*)(a.x + (size_t)m * D) + lane; float s = 0.f;
        u32x2* o8 = (u32x2*)(xb + (size_t)m * D) + lane;
#pragma unroll
        for (int j = 0; j < 4; ++j) { const f32x4 v = xr[64 * j]; s += (v[0] * v[0] + v[1] * v[1]) + (v[2] * v[2] + v[3] * v[3]); u32x2 w; w.x = cvtpk(v[0], v[1]); w.y = cvtpk(v[2], v[3]); o8[64 * j] = w; }
        s = wave_sum(s);
        if (lane < 16) ssq[(size_t)m * 16 + lane] = (lane == 0) ? s : 0.f;
    }
}
__device__ __forceinline__ void final_norm(const Args& a, int G, int bx) {
    const int tid = opaque_tid(), lane = tid & 63, wid = __builtin_amdgcn_readfirstlane(tid >> 6), gw = bx * 8 + wid, NGW = G * 8;
    for (int m = gw; m < M; m += NGW) {
        f32x4* xr = (f32x4*)(a.out + (size_t)m * D) + lane; const f32x4* gr = (const f32x4*)a.norm_final_g + lane;
        f32x4 v[4]; float s = 0.f;
#pragma unroll
        for (int j = 0; j < 4; ++j) { v[j] = xr[64 * j]; s += (v[j][0] * v[j][0] + v[j][1] * v[j][1]) + (v[j][2] * v[j][2] + v[j][3] * v[j][3]); }
        const float rs = rsqrtf(wave_sum(s) * (1.f / D) + 1e-6f);
#pragma unroll
        for (int j = 0; j < 4; ++j) xr[64 * j] = v[j] * rs * gr[64 * j];
    }
}

__device__ __forceinline__ void attn_prep(LAS unsigned char* L, const bf16_t* Z, const float* ZF, const float* fgb, float* cs, float* kpm, int bh) {
    const int tid = opaque_tid(), lane = tid & 63, wid = tid >> 6, b = bh / 6, h = bh % 6;
    LAS float* wtot = (LAS float*)L;
    LAS float* tm = (LAS float*)(L + 64);
    LAS float* tl = (LAS float*)(L + 64 + 2048);
    const float fb = fgb[h];
    float lf[16]; float s = 0.f;
    const size_t r0 = (size_t)b * T + 16 * tid;
#pragma unroll
    for (int i = 0; i < 16; ++i) { const float x = ZF[(r0 + i) * ZFP + ZF_FA + h] + fb; lf[i] = fminf(x, 0.f) - log1pf(__expf(-fabsf(x))); s += lf[i]; }
    float inc = s;
#pragma unroll
    for (int o = 1; o < 64; o <<= 1) { const float t = __shfl_up(inc, o); if (lane >= o) inc += t; }
    if (lane == 63) wtot[wid] = inc;
    float mx = 0.f;
#pragma unroll 4
    for (int i = 0; i < 16; ++i) {
        const u32x4* kp = (const u32x4*)(Z + (r0 + i) * ZP + Z_KA + h * 64); float n2 = 0.f;
#pragma unroll
        for (int c = 0; c < 8; ++c) { const u32x4 w = kp[c];
#pragma unroll
            for (int e = 0; e < 4; ++e) { const float lo = bflo(w[e]), hi = bfhi(w[e]); n2 += lo * lo + hi * hi; } }
        mx = fmaxf(mx, n2);
    }
    tm[tid] = mx;
    __syncthreads();
    float run = inc - s;
    for (int w = 0; w < wid; ++w) run += wtot[w];
#pragma unroll
    for (int i = 0; i < 16; ++i) { run += lf[i]; cs[(size_t)bh * T + 16 * tid + i] = run; }
    if (tid < 128) tl[tid] = fmaxf(fmaxf(tm[4 * tid], tm[4 * tid + 1]), fmaxf(tm[4 * tid + 2], tm[4 * tid + 3]));
    __syncthreads();
    if (tid < 128) { float p = 0.f; for (int i = 0; i <= tid; ++i) p = fmaxf(p, tl[i]); kpm[bh * 128 + tid] = p; }
    __syncthreads();
}

constexpr int AK_STR = 144, AV_STR = 192, AK_BYTES = 64 * AK_STR, AV_BYTES = 64 * AV_STR, A_VOFF = 2 * AK_BYTES, A_BOFF = A_VOFF + 2 * AV_BYTES, A_VOTE = A_BOFF + 512;
__device__ __forceinline__ void attn_unit(LAS unsigned char* L, const bf16_t* Z, const float* cs, const float* kpm, bf16_t* MIX, int bh, int qb) {
    const int tid = opaque_tid(), lane = tid & 63, r32 = lane & 31, hi = lane >> 5; const int wid = __builtin_amdgcn_readfirstlane(tid >> 6);
    const int b = bh / 6, h = bh % 6; const size_t rowbase = (size_t)b * T; const int q0 = qb * 256, t0 = q0 + wid * 32;
    bf16x8 qr[4];
    { const bf16_t* Qp = Z + (rowbase + t0 + r32) * ZP + Z_QA + h * 64 + hi * 8;
#pragma unroll
      for (int d0 = 0; d0 < 4; ++d0) qr[d0] = *(const bf16x8*)(Qp + d0 * 16); }
    float qn2 = 0.f;
#pragma unroll
    for (int d0 = 0; d0 < 4; ++d0)
#pragma unroll
        for (int e = 0; e < 8; ++e) { const float v = bf2f((unsigned short)qr[d0][e]); qn2 += v * v; }
    qn2 += __shfl_xor(qn2, 32);
    const float qn = sqrtf(qn2) * 1.001f;
    const float* csb = cs + (size_t)bh * T; const float cref = csb[q0];
    const int srow = tid >> 3, sch = tid & 7;
    const bf16_t* Kg = Z + rowbase * ZP + Z_KA + h * 64 + sch * 8; const bf16_t* Vg = Z + rowbase * ZP + Z_VA + h * 64 + sch * 8;
    int j = (q0 + 256) / 64 - 1;
    u32x4 kreg = *(const u32x4*)(Kg + (size_t)(64 * j + srow) * ZP), vreg = *(const u32x4*)(Vg + (size_t)(64 * j + srow) * ZP);
    float cval = (tid < 64) ? csb[64 * j + tid] : 0.f;
    *(LAS u32x4*)(L + srow * AK_STR + sch * 16) = kreg; *(LAS u32x4*)(L + A_VOFF + srow * AV_STR + sch * 16) = vreg;
    if (tid < 64) ((LAS float*)(L + A_BOFF))[tid] = (cref - cval) * LOG2E;
    __syncthreads();
    float m = -1e30f, l = 0.f; f32x16 o[2]; o[0] = f32x16{}; o[1] = f32x16{};
    int buf = 0;
    const int tq = (lane & 15) >> 2, tp = lane & 3, tg1 = (lane >> 4) & 1;
    for (;;) {
        const bool more = j > 0;
        if (more) { kreg = *(const u32x4*)(Kg + (size_t)(64 * (j - 1) + srow) * ZP); vreg = *(const u32x4*)(Vg + (size_t)(64 * (j - 1) + srow) * ZP); cval = (tid < 64) ? csb[64 * (j - 1) + tid] : 0.f; }
        const int k0 = 64 * j;
        if (k0 <= t0 + 31) {
            const LAS unsigned char* Kb = L + buf * AK_BYTES; const LAS unsigned char* Vb = L + A_VOFF + buf * AV_BYTES;
            const LAS float* kbp = (const LAS float*)(L + A_BOFF + buf * 256) + 4 * hi;
            f32x16 p0, p1;
#pragma unroll
            for (int i = 0; i < 4; ++i) { const f32x4 ta = *(const LAS f32x4*)(kbp + 8 * i), tb = *(const LAS f32x4*)(kbp + 32 + 8 * i);
#pragma unroll
                for (int e = 0; e < 4; ++e) { p0[4 * i + e] = ta[e]; p1[4 * i + e] = tb[e]; } }
#pragma unroll
            for (int d0 = 0; d0 < 4; ++d0) {
                const bf16x8 a0 = *(const LAS bf16x8*)(Kb + r32 * AK_STR + d0 * 32 + hi * 16), a1 = *(const LAS bf16x8*)(Kb + (32 + r32) * AK_STR + d0 * 32 + hi * 16);
                p0 = __builtin_amdgcn_mfma_f32_32x32x16_bf16(a0, qr[d0], p0, 0, 0, 0); p1 = __builtin_amdgcn_mfma_f32_32x32x16_bf16(a1, qr[d0], p1, 0, 0, 0);
            }
            if (k0 + 63 > t0) { const int tt = t0 + r32;
#pragma unroll
                for (int r = 0; r < 16; ++r) { const int kv = k0 + crow(r, hi); if (kv > tt) p0[r] = -INFINITY; if (kv + 32 > tt) p1[r] = -INFINITY; } }
            float mx = fmaxf(p0[0], p1[0]);
#pragma unroll
            for (int r = 1; r < 16; ++r) mx = fmaxf(mx, fmaxf(p0[r], p1[r]));
            mx = fmaxf(mx, __shfl_xor(mx, 32));
            const float mnew = fmaxf(m, mx), alpha = __builtin_amdgcn_exp2f(m - mnew);
            float sum = 0.f;
#pragma unroll
            for (int r = 0; r < 16; ++r) { p0[r] = __builtin_amdgcn_exp2f(p0[r] - mnew); p1[r] = __builtin_amdgcn_exp2f(p1[r] - mnew); sum += p0[r] + p1[r]; }
            l = l * alpha + sum; m = mnew;
#pragma unroll
            for (int r = 0; r < 16; ++r) { o[0][r] *= alpha; o[1][r] *= alpha; }
            u32x4 pw[4];
#pragma unroll
            for (int e = 0; e < 4; ++e) { pw[0][e] = cvtpk(p0[2 * e], p0[2 * e + 1]); pw[1][e] = cvtpk(p0[8 + 2 * e], p0[9 + 2 * e]); pw[2][e] = cvtpk(p1[2 * e], p1[2 * e + 1]); pw[3][e] = cvtpk(p1[8 + 2 * e], p1[9 + 2 * e]); }
#pragma unroll
            for (int dh = 0; dh < 2; ++dh)
#pragma unroll
                for (int s = 0; s < 4; ++s) {
                    const LAS unsigned char* ap = Vb + (16 * s + 4 * hi + tq) * AV_STR + (32 * dh + 16 * tg1 + 4 * tp) * 2;
                    const bf16x8 vf = cat8(trread(ap), trread(ap + 8 * AV_STR));
                    o[dh] = __builtin_amdgcn_mfma_f32_32x32x16_bf16(vf, __builtin_bit_cast(bf16x8, pw[s]), o[dh], 0, 0, 0);
                }
        }
        if (more) {
            const int nb = buf ^ 1;
            *(LAS u32x4*)(L + nb * AK_BYTES + srow * AK_STR + sch * 16) = kreg; *(LAS u32x4*)(L + A_VOFF + nb * AV_BYTES + srow * AV_STR + sch * 16) = vreg;
            if (tid < 64) ((LAS float*)(L + A_BOFF + nb * 256))[tid] = (cref - cval) * LOG2E;
            const float kmax = sqrtf(kpm[bh * 128 + j - 1]) * 1.001f, bmax = (cref - csb[64 * (j - 1) + 63]) * LOG2E;
            const int vote = __all((qn * kmax + bmax - m) < -170.f);
            if (lane == 0) ((LAS int*)(L + A_VOTE + nb * 32))[wid] = vote;
        }
        __syncthreads();
        if (!more) break;
        { const LAS int* vp = (const LAS int*)(L + A_VOTE + (buf ^ 1) * 32); int all = 1;
#pragma unroll
          for (int w = 0; w < 8; ++w) all &= vp[w];
          if (all) break; }
        --j; buf ^= 1;
    }
    l += __shfl_xor(l, 32);
    const float inv = 1.0f / l;
    bf16_t* Op = MIX + (rowbase + t0 + r32) * D + MIX_ATT + h * 64;
#pragma unroll
    for (int dh = 0; dh < 2; ++dh)
#pragma unroll
        for (int g = 0; g < 4; ++g) { u32x2 w; w.x = cvtpk(o[dh][4 * g] * inv, o[dh][4 * g + 1] * inv); w.y = cvtpk(o[dh][4 * g + 2] * inv, o[dh][4 * g + 3] * inv); *(u32x2*)(Op + 32 * dh + 8 * g + 4 * hi) = w; }
    __syncthreads();
}

__device__ __forceinline__ void conv_item(LAS unsigned char* L, const bf16_t* Z, const float* cw, const float* cb, const float* lg, const float* lb, bf16_t* MIX, int item) {
    const int tid = opaque_tid(), lane = tid & 63, wid = tid >> 6; const int b = item >> 8, t0 = (item & 255) * 32; const size_t rowbase = (size_t)b * T;
    LAS float* hs = (LAS float*)L;
    LAS float* ob = (LAS float*)(L + 62 * 1024);
    { u32x4 av[4], gv[4];
#pragma unroll
      for (int k = 0; k < 4; ++k) { const int ci = tid + 512 * k, r = ci >> 5, ch = ci & 31, t = t0 - 30 + r; av[k] = (u32x4){0u, 0u, 0u, 0u}; gv[k] = av[k];
          if (ci < 62 * 32 && t >= 0) { const bf16_t* p = Z + (rowbase + t) * ZP + Z_CV + ch * 8; av[k] = *(const u32x4*)p; gv[k] = *(const u32x4*)(p + 256); } }
#pragma unroll
      for (int k = 0; k < 4; ++k) { const int ci = tid + 512 * k, r = ci >> 5, ch = ci & 31; f32x4 h0, h1;
#pragma unroll
          for (int e = 0; e < 2; ++e) { h0[2 * e] = bflo(av[k][e]) * sigmoidf_(bflo(gv[k][e])); h0[2 * e + 1] = bfhi(av[k][e]) * sigmoidf_(bfhi(gv[k][e])); h1[2 * e] = bflo(av[k][2 + e]) * sigmoidf_(bflo(gv[k][2 + e])); h1[2 * e + 1] = bfhi(av[k][2 + e]) * sigmoidf_(bfhi(gv[k][2 + e])); }
          if (ci < 62 * 32) { *(LAS f32x4*)(hs + r * 256 + ch * 8) = h0; *(LAS f32x4*)(hs + r * 256 + ch * 8 + 4) = h1; } } }
    __syncthreads();
    { const int c = tid & 255, half = tid >> 8; float w[31], hw[46];
#pragma unroll
      for (int jj = 0; jj < 31; ++jj) w[jj] = cw[jj * 256 + c];
      const float bias = cb[c];
#pragma unroll
      for (int i = 0; i < 46; ++i) hw[i] = hs[(16 * half + i) * 256 + c];
#pragma unroll
      for (int tt = 0; tt < 16; ++tt) { float acc = bias;
#pragma unroll
          for (int jj = 0; jj < 31; ++jj) acc += w[jj] * hw[tt + jj];
          ob[(16 * half + tt) * 256 + c] = acc; } }
    __syncthreads();
    { const f32x4 g4 = *(const f32x4*)(lg + 4 * lane), b4 = *(const f32x4*)(lb + 4 * lane);
#pragma unroll
      for (int k = 0; k < 4; ++k) { const int tl = 4 * wid + k; const f32x4 v = *(const LAS f32x4*)(ob + tl * 256 + 4 * lane);
          const float mu = wave_sum((v[0] + v[1]) + (v[2] + v[3])) * (1.f / 256.f); const f32x4 d = v - mu;
          const float var = wave_sum((d[0] * d[0] + d[1] * d[1]) + (d[2] * d[2] + d[3] * d[3])) * (1.f / 256.f); const float rs = rsqrtf(var + 1e-5f);
          const f32x4 y = d * rs * g4 + b4; u32x2 w; w.x = cvtpk(siluf_(y[0]), siluf_(y[1])); w.y = cvtpk(siluf_(y[2]), siluf_(y[3]));
          *(u32x2*)(MIX + (rowbase + t0 + tl) * D + MIX_CNV + 4 * lane) = w; } }
    __syncthreads();
}

__device__ __forceinline__ void hgrn_load_v(LAS unsigned char* vimg, const bf16_t* Z, size_t R0, int hh, int lane) {
#pragma unroll
    for (int it = 0; it < 8; ++it) { const int idx = it * 64 + lane, row = idx >> 3, ch = idx & 7; *(LAS u32x4*)(vimg + row * 128 + ch * 16) = *(const u32x4*)(Z + (R0 + row) * ZP + Z_IH + hh * 64 + ch * 8); }
}
__device__ __forceinline__ void hgrn_elem(float z, float lb, float oml, float& kk, float& g) {
    const float ez = __expf(-fabsf(z)), r = fast_rcp(1.f + ez), sp = r, sn = ez * r;
    const float sg = z >= 0.f ? sp : sn, oms = z >= 0.f ? sn : sp;
    const float f = fmaxf(lb + oml * sg, 1e-30f); kk = oml * oms; g = __logf(f);
}
__device__ __forceinline__ void hgrn_a(LAS unsigned char* Lw, const bf16_t* Z, bf16_t* MIX, const float* ZF, bf16_t* KT, const float* lbl, int layer, float* UT, float* EM, float* EE, int item, int lane) {
    const int c = item & 127, bhh = item >> 7, hh = bhh % 6, b = bhh / 6;
    const size_t R0 = (size_t)b * T + 64 * c; const int col = hh * 64 + lane;
    float lb;
    { float lg[4], mx = -1e30f;
#pragma unroll
      for (int i = 0; i < 4; ++i) { lg[i] = lbl[i * 384 + col]; mx = fmaxf(mx, lg[i]); }
      float se = 0.f, num = 0.f;
#pragma unroll
      for (int i = 0; i < 4; ++i) { const float e = __expf(lg[i] - mx); se += e; if (i >= 1 && i <= layer) num += e; }
      lb = num / se; }
    const float oml = 1.f - lb;
    LAS unsigned char* kimg = Lw; LAS unsigned char* vimg = Lw + 8192;
    hgrn_load_v(vimg, Z, R0, hh, lane);
    float nb = 0.f;
#pragma unroll 1
    for (int bt = 0; bt < 2; ++bt) {
        const int base = 16 - 16 * bt; float zv[16]; unsigned short qv[16];
#pragma unroll
        for (int i = 0; i < 16; ++i) { zv[i] = ZF[(R0 + base + i) * ZFP + ZF_FH + col]; qv[i] = Z[(R0 + base + i) * ZP + Z_QH + col]; }
#pragma unroll
        for (int i = 15; i >= 0; --i) { const int t = base + i; float kk, g; hgrn_elem(zv[i], lb, oml, kk, g);
            const unsigned short qt = f2bf(bf2f(qv[i]) * __expf(-nb)), kt = f2bf(kk * __expf(nb));
            MIX[(R0 + t) * D + MIX_HG + col] = qt; KT[(R0 + t) * 384 + col] = kt; *(LAS unsigned short*)(kimg + t * 128 + lane * 2) = kt; nb += g; }
    }
    float fa = 0.f;
#pragma unroll 1
    for (int bt = 0; bt < 2; ++bt) {
        const int base = 32 + 16 * bt; float zv[16]; unsigned short qv[16];
#pragma unroll
        for (int i = 0; i < 16; ++i) { zv[i] = ZF[(R0 + base + i) * ZFP + ZF_FH + col]; qv[i] = Z[(R0 + base + i) * ZP + Z_QH + col]; }
#pragma unroll
        for (int i = 0; i < 16; ++i) { const int t = base + i; float kk, g; hgrn_elem(zv[i], lb, oml, kk, g); fa += g;
            const unsigned short qt = f2bf(bf2f(qv[i]) * __expf(fa)), kt = f2bf(kk * __expf(-fa));
            MIX[(R0 + t) * D + MIX_HG + col] = qt; KT[(R0 + t) * 384 + col] = kt; *(LAS unsigned short*)(kimg + t * 128 + lane * 2) = kt; }
    }
    EM[(size_t)item * 64 + lane] = __expf(nb); EE[(size_t)item * 64 + lane] = __expf(nb + fa);
    const float usc = __expf(fa);
    asm volatile("s_waitcnt lgkmcnt(0)" ::: "memory");
    const int tq = (lane & 15) >> 2, tp = lane & 3, tg1 = (lane >> 4) & 1, hi = lane >> 5, r32 = lane & 31;
#pragma unroll
    for (int vh = 0; vh < 2; ++vh)
#pragma unroll
        for (int dh = 0; dh < 2; ++dh) {
            f32x16 acc = f32x16{};
#pragma unroll
            for (int st = 0; st < 4; ++st) {
                const LAS unsigned char* ap = vimg + (16 * st + 8 * hi + tq) * 128 + (32 * vh + 16 * tg1 + 4 * tp) * 2;
                const LAS unsigned char* bp = kimg + (16 * st + 8 * hi + tq) * 128 + (32 * dh + 16 * tg1 + 4 * tp) * 2;
                acc = __builtin_amdgcn_mfma_f32_32x32x16_bf16(cat8(trread(ap), trread(ap + 4 * 128)), cat8(trread(bp), trread(bp + 4 * 128)), acc, 0, 0, 0);
            }
            const float sc = __shfl(usc, 32 * dh + r32);
#pragma unroll
            for (int r = 0; r < 16; ++r) UT[(size_t)item * 4096 + (32 * vh + crow(r, hi)) * 64 + 32 * dh + r32] = acc[r] * sc;
        }
    asm volatile("s_waitcnt lgkmcnt(0)" ::: "memory");
}
__device__ __forceinline__ void hgrn_scan(const float* UT, const float* EM, const float* EE, bf16_t* SP, int item) {
    const int bhh = item >> 3, seg = item & 7, e = seg * 512 + opaque_tid(), dk = e & 63;
    float S = 0.f;
#pragma unroll 1
    for (int c0 = 0; c0 < 128; c0 += 16) {
        float u[16], em[16], ee[16];
#pragma unroll
        for (int i = 0; i < 16; ++i) { const size_t it = (size_t)bhh * 128 + c0 + i; u[i] = UT[it * 4096 + e]; em[i] = EM[it * 64 + dk]; ee[i] = EE[it * 64 + dk]; }
#pragma unroll
        for (int i = 0; i < 16; ++i) { const size_t it = (size_t)bhh * 128 + c0 + i; SP[it * 4096 + e] = f2bf(em[i] * S); S = ee[i] * S + u[i]; }
    }
}
__device__ __forceinline__ void hgrn_o(LAS unsigned char* Lw, const bf16_t* Z, const bf16_t* KT, const bf16_t* SP, const float* ng, bf16_t* MIX, int item, int lane) {
    const int c = item & 127, bhh = item >> 7, hh = bhh % 6, b = bhh / 6;
    const size_t R0 = (size_t)b * T + 64 * c;
    const int tq = (lane & 15) >> 2, tp = lane & 3, tg1 = (lane >> 4) & 1, hi = lane >> 5, r32 = lane & 31;
    LAS unsigned char* vimg = Lw;
    hgrn_load_v(vimg, Z, R0, hh, lane);
    asm volatile("s_waitcnt lgkmcnt(0)" ::: "memory");
#pragma unroll 1
    for (int tau = 0; tau < 2; ++tau) {
        bf16x8 qf[4];
        { const bf16_t* qp = MIX + (R0 + 32 * tau + r32) * D + MIX_HG + hh * 64 + 8 * hi;
#pragma unroll
          for (int st = 0; st < 4; ++st) qf[st] = *(const bf16x8*)(qp + 16 * st); }
        f32x16 X[2];
#pragma unroll
        for (int sh = 0; sh < 2; ++sh) { X[sh] = f32x16{}; const bf16_t* kp = KT + (R0 + 32 * sh + r32) * 384 + hh * 64 + 8 * hi;
#pragma unroll
            for (int st = 0; st < 4; ++st) X[sh] = __builtin_amdgcn_mfma_f32_32x32x16_bf16(*(const bf16x8*)(kp + 16 * st), qf[st], X[sh], 0, 0, 0); }
        const int t = 32 * tau + r32;
#pragma unroll
        for (int sh = 0; sh < 2; ++sh)
#pragma unroll
            for (int r = 0; r < 16; ++r) if (32 * sh + crow(r, hi) > t) X[sh][r] = 0.f;
        u32x4 pw[4];
#pragma unroll
        for (int e = 0; e < 4; ++e) { pw[0][e] = cvtpk(X[0][2 * e], X[0][2 * e + 1]); pw[1][e] = cvtpk(X[0][8 + 2 * e], X[0][9 + 2 * e]); pw[2][e] = cvtpk(X[1][2 * e], X[1][2 * e + 1]); pw[3][e] = cvtpk(X[1][8 + 2 * e], X[1][9 + 2 * e]); }
        f32x16 Y[2];
#pragma unroll
        for (int vh = 0; vh < 2; ++vh) { Y[vh] = f32x16{};
#pragma unroll
            for (int st = 0; st < 4; ++st) { const LAS unsigned char* ap = vimg + (16 * st + 4 * hi + tq) * 128 + (32 * vh + 16 * tg1 + 4 * tp) * 2;
                Y[vh] = __builtin_amdgcn_mfma_f32_32x32x16_bf16(cat8(trread(ap), trread(ap + 8 * 128)), __builtin_bit_cast(bf16x8, pw[st]), Y[vh], 0, 0, 0); }
            const bf16_t* sp = SP + ((size_t)item * 64 + 32 * vh + r32) * 64 + 8 * hi;
#pragma unroll
            for (int ds = 0; ds < 4; ++ds) Y[vh] = __builtin_amdgcn_mfma_f32_32x32x16_bf16(*(const bf16x8*)(sp + 16 * ds), qf[ds], Y[vh], 0, 0, 0); }
        float ss = 0.f;
#pragma unroll
        for (int r = 0; r < 16; ++r) ss += Y[0][r] * Y[0][r] + Y[1][r] * Y[1][r];
        ss += __shfl_xor(ss, 32);
        const float rs = rsqrtf(ss * (1.f / 64.f) + 1e-6f);
        const size_t R = R0 + t;
#pragma unroll
        for (int vh = 0; vh < 2; ++vh)
#pragma unroll
            for (int g4 = 0; g4 < 4; ++g4) { const int v0 = 32 * vh + 8 * g4 + 4 * hi;
                const u32x2 gw = *(const u32x2*)(Z + R * ZP + Z_GH + hh * 64 + v0); const f32x4 n4 = *(const f32x4*)(ng + v0);
                const float y0 = Y[vh][4 * g4] * rs * n4[0] * siluf_(bflo(gw.x)), y1 = Y[vh][4 * g4 + 1] * rs * n4[1] * siluf_(bfhi(gw.x));
                const float y2 = Y[vh][4 * g4 + 2] * rs * n4[2] * siluf_(bflo(gw.y)), y3 = Y[vh][4 * g4 + 3] * rs * n4[3] * siluf_(bfhi(gw.y));
                u32x2 w; w.x = cvtpk(y0, y1); w.y = cvtpk(y2, y3); *(u32x2*)(MIX + R * D + MIX_HG + hh * 64 + v0) = w; }
    }
    asm volatile("s_waitcnt lgkmcnt(0)" ::: "memory");
}

#define XB_TMO      128
#define XB_XCNT(j)  (256  + 64 * (j))
#define XB_XSUB(j)  (1280 + 64 * (j))
#define XB_XGEN(j)  (2304 + 64 * (j))
#define XB_TOP      3328
#define XB_TOPGEN   3392
#define XCD_BAR_WORDS 3456
#define XB_SPIN_CAP (1u << 18)

__device__ __forceinline__ unsigned xb_ld(unsigned* p)              { return __hip_atomic_load(p, __ATOMIC_RELAXED, __HIP_MEMORY_SCOPE_AGENT); }
__device__ __forceinline__ unsigned xb_add(unsigned* p, unsigned v) { return __hip_atomic_fetch_add(p, v, __ATOMIC_RELAXED, __HIP_MEMORY_SCOPE_AGENT); }
__device__ __forceinline__ unsigned xb_xcc_id() { return (unsigned)__builtin_amdgcn_s_getreg((3 << 11) | 20) & 0xFu; }
#define XB_SPIN(cond, bar) do { unsigned _sp = 0; while (cond) { __builtin_amdgcn_s_sleep(1); \
    if ((++_sp & 255u) == 0u) { if (xb_ld(&(bar)[XB_TMO])) break; if (_sp > XB_SPIN_CAP) { atomicAdd(&(bar)[XB_TMO], 1u); break; } } } } while (0)

struct XcdBarrier {
    unsigned* bar; unsigned x;
    volatile LAS unsigned* st;
};

__device__ __forceinline__ XcdBarrier xcd_barrier_post(unsigned* bar, volatile LAS unsigned* st) {
    XcdBarrier b; b.bar = bar; b.x = xb_xcc_id(); b.st = st;
    if (threadIdx.x == 0) (void)xb_add(&bar[XB_XCNT(b.x)], 1u);
    return b;
}
__device__ __forceinline__ void xcd_barrier_complete(unsigned* bar, unsigned x, unsigned& nloc, unsigned& nx) {
    const unsigned G = gridDim.x * gridDim.y * gridDim.z;
    unsigned sum, cnt, mine, sp = 0u;
    for (;;) {
        sum = 0u; cnt = 0u; mine = 0u;
#pragma unroll
        for (unsigned j = 0; j < 16; ++j) { const unsigned c = xb_ld(&bar[XB_XCNT(j)]); sum += c; cnt += (c > 0u) ? 1u : 0u; mine = (j == x) ? c : mine; }
        if (sum == G) break;
        __builtin_amdgcn_s_sleep(1);
        if ((++sp & 255u) == 0u) { if (xb_ld(&bar[XB_TMO])) break; if (sp > XB_SPIN_CAP) { atomicAdd(&bar[XB_TMO], 1u); break; } }
    }
    nloc = mine > 0u ? mine : 1u; nx = cnt > 0u ? cnt : 1u;
}

__device__ __forceinline__ void xcd_barrier(const XcdBarrier& b) {
    asm volatile("s_waitcnt vmcnt(0)" ::: "memory");
    __syncthreads();
    if (threadIdx.x == 0) {
        unsigned* bar = b.bar;
        __builtin_amdgcn_s_waitcnt(0);
        unsigned nloc = b.st[0], nx = b.st[1];
        if (nloc == 0u) { xcd_barrier_complete(bar, b.x, nloc, nx); b.st[0] = nloc; b.st[1] = nx; }
        const unsigned old = xb_add(&bar[XB_XSUB(b.x)], 1u);
        const unsigned gen = old / nloc;
        if (old + 1u == (gen + 1u) * nloc) {
            __builtin_amdgcn_fence(__ATOMIC_RELEASE, "agent");
            asm volatile("s_waitcnt vmcnt(0)" ::: "memory");
            const unsigned og = xb_add(&bar[XB_TOP], 1u);
            const unsigned tg = og / nx;
            if (og + 1u == (tg + 1u) * nx) xb_add(&bar[XB_TOPGEN], 1u);
            else XB_SPIN(xb_ld(&bar[XB_TOPGEN]) == tg, bar);
            __builtin_amdgcn_fence(__ATOMIC_ACQUIRE, "agent");
            xb_add(&bar[XB_XGEN(b.x)], 1u);
            asm volatile("s_waitcnt vmcnt(0)" ::: "memory");
        } else {
            XB_SPIN(xb_ld(&bar[XB_XGEN(b.x)]) == gen, bar);
            __builtin_amdgcn_fence(__ATOMIC_ACQUIRE, "agent");
            asm volatile("s_waitcnt vmcnt(0)" ::: "memory");
        }
    }
    __syncthreads();
}

#ifndef REP_P
#define REP_P 1
#endif
#ifndef REP_E
#define REP_E 1
#endif
#ifndef REP_A
#define REP_A 1
#endif
#ifndef REP_C
#define REP_C 1
#endif
#ifndef REP_D
#define REP_D 1
#endif
#ifndef REP_F
#define REP_F 1
#endif
#ifndef REP_B
#define REP_B 1
#endif
#ifndef XSYNC
#define XSYNC 0
#endif
__global__ void __launch_bounds__(512, 2) fwd_megakernel(Args a) {
    extern __shared__ __attribute__((aligned(16))) unsigned char lds_raw[];
    cg::grid_group grid = cg::this_grid();
    LAS unsigned char* lds = (LAS unsigned char*)lds_raw;
    const int G = gridDim.x, bx = blockIdx.x;
    volatile LAS unsigned* MISC = (volatile LAS unsigned*)(lds + LDS_BYTES - 64);
    if (threadIdx.x < 16) MISC[threadIdx.x] = 0u;
    if (bx == 0) for (int u = threadIdx.x; u < 8192; u += 512) ((unsigned*)a.ws)[u] = 0u;
    unsigned char* ws = a.ws;
    bf16_t* win_t = (bf16_t*)(ws + WS_WIN); bf16_t* wout_t = (bf16_t*)(ws + WS_WOUT); bf16_t* wfi_t = (bf16_t*)(ws + WS_WFI); bf16_t* wfo_t = (bf16_t*)(ws + WS_WFO);
    bf16_t* Z = (bf16_t*)(ws + WS_Z); bf16_t* H = Z; float* ZF = (float*)(ws + WS_ZF); bf16_t* SP = (bf16_t*)(ws + WS_ZF);
    bf16_t* XB = (bf16_t*)(ws + WS_XB); float* UT = a.out;     bf16_t* MIX = (bf16_t*)(ws + WS_MIX); bf16_t* KT = (bf16_t*)(ws + WS_KT);
    float* SSQ = (float*)(ws + WS_SSQ); float* CS = (float*)(ws + WS_CS); float* KPM = (float*)(ws + WS_KPM); float* EM = (float*)(ws + WS_EM); float* EE = (float*)(ws + WS_EE);

#ifndef SKIP_P
    for (int rep = 0; rep < REP_P; ++rep) prologue(a, lds, G, bx);
#endif
    grid.sync();
    const XcdBarrier xbar = xcd_barrier_post((unsigned*)a.ws, MISC);
#define GSYNC() xcd_barrier(xbar)
#pragma unroll 1
    for (int l = 0; l < DEPTH; ++l) {
#ifndef SKIP_A
        for (int rep = 0; rep < REP_A; ++rep)
        { pg8::Gemm g{XB, win_t + (size_t)l * NIN * D, M, NIN, D}; pg8::StaticOrder S; S.init(M, NIN, G, bx); EpiIn E{Z, ZF, SSQ};
          pg8::gemm_phase<EpiIn, pg8::StaticOrder, true, true>(lds, g, S, E); }
#endif
        GSYNC();
#ifndef SKIP_B
        for (int rep = 0; rep < REP_B; ++rep) {
        for (int it = bx; it < 24 + 1024; it += G) {
            if (it < 24) attn_prep(lds, Z, ZF, a.fgate_b + l * 6, CS, KPM, it);
            else conv_item(lds, Z, a.conv_w + (size_t)l * 31 * 256, a.conv_b + l * 256, a.conv_ln_g + l * 256, a.conv_ln_b + l * 256, MIX, it - 24);
        }
        __syncthreads();
        { const int tid = opaque_tid(), lane = tid & 63, wid = __builtin_amdgcn_readfirstlane(tid >> 6);
          for (int it = bx * 8 + wid; it < NHITEM; it += G * 8) hgrn_a(lds + wid * 16384, Z, MIX, ZF, KT, a.lb_logits, l, UT, EM, EE, it, lane); }
        __syncthreads(); }
#endif
        GSYNC();
#ifndef SKIP_C
        for (int rep = 0; rep < REP_C; ++rep) {
        for (int it = bx; it < 192; it += G) hgrn_scan(UT, EM, EE, SP, it);
        for (;;) {
            if (threadIdx.x == 0) MISC[4] = atomicAdd((unsigned*)a.ws + 4096 + 64 * (l * REP_C + rep), 1u);
            __syncthreads();
            const int pos = (int)MISC[4];
            if (pos >= 768) break;
            attn_unit(lds, Z, CS, KPM, MIX, pos % 24, 31 - pos / 24);
        }
        __syncthreads();
        }
        for (int xs = 0; xs < XSYNC; ++xs) GSYNC();
#endif
        GSYNC();
#ifndef SKIP_D
        for (int rep = 0; rep < REP_D; ++rep)
        { const int tid = opaque_tid(), lane = tid & 63, wid = __builtin_amdgcn_readfirstlane(tid >> 6);
          for (int it = bx * 8 + wid; it < NHITEM; it += G * 8) hgrn_o(lds + wid * 16384, Z, KT, SP, a.hgrn_norm_g + l * 64, MIX, it, lane); }
#endif
        GSYNC();
#ifndef SKIP_E
        for (int rep = 0; rep < ((l == 0) ? REP_E : 1); ++rep)
        { pg8::Gemm g{MIX, wout_t + (size_t)l * D * D, M, D, D}; pg8::StaticOrder S; S.init(M, D, G, bx); EpiRes<false> E{a.out, XB, SSQ};
          pg8::gemm_phase<EpiRes<false>, pg8::StaticOrder, true, true>(lds, g, S, E); }
#endif
        GSYNC();
#ifndef SKIP_F
        for (int rep = 0; rep < REP_F; ++rep)
        { pg8::Gemm g{XB, wfi_t + (size_t)l * NFF * D, M, NFF, D}; pg8::StaticOrder S; S.init(M, NFF, G, bx); EpiGlu E{H, SSQ};
          pg8::gemm_phase<EpiGlu, pg8::StaticOrder, true, true>(lds, g, S, E); }
#endif
        GSYNC();
#ifndef SKIP_G
        { pg8::Gemm g{H, wfo_t + (size_t)l * D * DFF, M, D, DFF}; pg8::StaticOrder S; S.init(M, D, G, bx);
          if (l < DEPTH - 1) { EpiRes<false> E{a.out, XB, SSQ}; pg8::gemm_phase<EpiRes<false>, pg8::StaticOrder, true, true>(lds, g, S, E); }
          else { EpiRes<true> E{a.out, XB, SSQ}; pg8::gemm_phase<EpiRes<true>, pg8::StaticOrder, true, true>(lds, g, S, E); } }
#endif
        GSYNC();
    }
#ifndef SKIP_N
    final_norm(a, G, bx);
#endif
}

extern "C" void kernel_launch(void* const* d_in, const int* in_sizes, int n_in, void* d_out, int out_size, void* d_ws, size_t ws_size, hipStream_t stream) {
    static int grid = 0;
    if (grid == 0) {
        if (n_in != 15 || out_size != M * D || ws_size < WS_END) { fprintf(stderr, "kernel_launch: unexpected problem (n_in %d out %d ws %zu)\n", n_in, out_size, ws_size); grid = -1; return; }
        int dev = 0, cus = 0, per = 0;
        hipGetDevice(&dev); hipDeviceGetAttribute(&cus, hipDeviceAttributeMultiprocessorCount, dev);
        hipFuncSetAttribute((const void*)fwd_megakernel, hipFuncAttributeMaxDynamicSharedMemorySize, LDS_BYTES);
        if (hipOccupancyMaxActiveBlocksPerMultiprocessor(&per, (const void*)fwd_megakernel, 512, LDS_BYTES) != hipSuccess || per < 1) { fprintf(stderr, "kernel_launch: occupancy query gave %d\n", per); per = 1; }
        (void)hipGetLastError();
        grid = cus * per;
        fprintf(stderr, "kernel_launch: grid %d (cus %d x %d), ws %zu\n", grid, cus, per, ws_size);
    }
    if (grid < 0) return;
    Args a{};
    a.x = (const float*)d_in[0]; a.norm_mix_g = (const float*)d_in[1]; a.w_in = (const float*)d_in[2]; a.fgate_b = (const float*)d_in[3]; a.conv_w = (const float*)d_in[4];
    a.conv_b = (const float*)d_in[5]; a.conv_ln_g = (const float*)d_in[6]; a.conv_ln_b = (const float*)d_in[7]; a.lb_logits = (const float*)d_in[8]; a.hgrn_norm_g = (const float*)d_in[9];
    a.w_out = (const float*)d_in[10]; a.norm_ffn_g = (const float*)d_in[11]; a.w_ffn_in = (const float*)d_in[12]; a.w_ffn_out = (const float*)d_in[13]; a.norm_final_g = (const float*)d_in[14];
    a.out = (float*)d_out; a.ws = (unsigned char*)d_ws;
    void* args[] = {&a};
    hipError_t e = hipLaunchCooperativeKernel((const void*)fwd_megakernel, dim3(grid), dim3(512), args, LDS_BYTES, stream);
    if (e != hipSuccess) fprintf(stderr, "kernel_launch: cooperative launch failed: %s (grid %d)\n", hipGetErrorString(e), grid);
}
```
